# Optimizing an MI355X kernel written in HIP

```python
import jax, jax.numpy as jnp
from jax import lax
import numpy as np

D_MODEL = 2048
BATCH = 4
SEQ = 4096
DEPTH = 2

GRID_W = 64
CTX_LEN = 256
HEAD_DIM = 128
AXIS_DIM = HEAD_DIM // 2
ATT_Q_HEADS = 12
ATT_KV_HEADS = 4
ATT_GROUPS = ATT_Q_HEADS // ATT_KV_HEADS
ATT_WIDTH = ATT_Q_HEADS * HEAD_DIM
KV_WIDTH = ATT_KV_HEADS * HEAD_DIM
AUX_WIDTH = D_MODEL - ATT_WIDTH
AUX_GROUPS = 4
AUX_GROUP_DIM = AUX_WIDTH // AUX_GROUPS
CONV_WIDTH = 3
POOL_WINDOWS = (2, 4, 8, 16)
WINDOW = 128
Q_BLOCK = 128
BAND = Q_BLOCK + 2 * WINDOW
ROPE_THETA = 10000.0
FFN_HIDDEN = -(-8 * D_MODEL // (3 * 256)) * 256
N_MOD = 6
EPS = 1e-6
NEG_INF = -1e30
ATT_SCALE = HEAD_DIM ** -0.5
IN_WIDTHS_AB = (ATT_WIDTH, KV_WIDTH, KV_WIDTH, AUX_WIDTH, AUX_WIDTH, AUX_WIDTH)
IN_WIDTHS_CD = (ATT_WIDTH, KV_WIDTH, KV_WIDTH, AUX_WIDTH)

kernel_name = "hybrid_prefix_dit_block"


def _split_points(widths):
    return [int(v) for v in np.cumsum(widths)[:-1]]


def _rms_norm(x, g):
    xf = x.astype(jnp.float32)
    y = xf * lax.rsqrt(jnp.mean(xf * xf, axis=-1, keepdims=True) + EPS)
    return (y * g.astype(jnp.float32)).astype(x.dtype)


def _modulate(h, shift, scale):
    return h * (1 + scale) + shift


def _axial_rope(n):
    rows = n // GRID_W
    row = jnp.broadcast_to(jnp.arange(rows, dtype=jnp.float32)[:, None], (rows, GRID_W)).reshape(-1)
    col = jnp.broadcast_to(jnp.arange(GRID_W, dtype=jnp.float32)[None, :], (rows, GRID_W)).reshape(-1)
    inv = jnp.power(ROPE_THETA, -jnp.arange(0, AXIS_DIM, 2, dtype=jnp.float32) / AXIS_DIM)
    ang_r = row[:, None] * inv
    ang_c = col[:, None] * inv
    return (jnp.cos(ang_r), jnp.sin(ang_r), jnp.cos(ang_c), jnp.sin(ang_c))


def _rotate(x, cos, sin):
    x1, x2 = jnp.split(x, 2, axis=-1)
    c = cos[:, None, :].astype(x.dtype)
    s = sin[:, None, :].astype(x.dtype)
    return jnp.concatenate([x1 * c - x2 * s, x2 * c + x1 * s], axis=-1)


def _apply_axial_rope(x, rope):
    cr, sr, cc, sc = rope
    return jnp.concatenate([_rotate(x[..., :AXIS_DIM], cr, sr), _rotate(x[..., AXIS_DIM:], cc, sc)], axis=-1)


def _softmax_attend(q, k, v, bias=None, sink=None):
    s = jnp.einsum('bqkgd,bnkd->bkgqn', q, k).astype(jnp.float32) * ATT_SCALE
    if bias is not None:
        s = s + bias
    if sink is not None:
        sink_col = jnp.broadcast_to(sink.astype(jnp.float32)[None, :, :, None, None], s.shape[:-1] + (1,))
        p = jax.nn.softmax(jnp.concatenate([s, sink_col], axis=-1), axis=-1)[..., :-1]
    else:
        p = jax.nn.softmax(s, axis=-1)
    return jnp.einsum('bkgqn,bnkd->bqkgd', p.astype(v.dtype), v)


def _dense_latent_attention(q, k, v, kc, vc):
    B, S = q.shape[0], q.shape[1]
    nb = S // Q_BLOCK
    k_all = jnp.concatenate([kc, k], axis=1)
    v_all = jnp.concatenate([vc, v], axis=1)
    qb = jnp.moveaxis(q.reshape(B, nb, Q_BLOCK, ATT_KV_HEADS, ATT_GROUPS, HEAD_DIM), 1, 0)
    o = lax.map(lambda qi: _softmax_attend(qi, k_all, v_all), qb)
    return jnp.moveaxis(o, 0, 1).reshape(B, S, ATT_WIDTH)


def _window_latent_attention(q, k, v, kc, vc, sink):
    B, S = q.shape[0], q.shape[1]
    nb = S // Q_BLOCK
    pad = ((0, 0), (WINDOW, WINDOW), (0, 0), (0, 0))
    kp = jnp.pad(k, pad)
    vp = jnp.pad(v, pad)
    qb = jnp.moveaxis(q.reshape(B, nb, Q_BLOCK, ATT_KV_HEADS, ATT_GROUPS, HEAD_DIM), 1, 0)
    ctx_bias = jnp.zeros((Q_BLOCK, kc.shape[1]), jnp.float32)

    def block(args):
        qi, bi = args
        start = bi * Q_BLOCK
        kb = lax.dynamic_slice_in_dim(kp, start, BAND, axis=1)
        vb = lax.dynamic_slice_in_dim(vp, start, BAND, axis=1)
        kpos = start - WINDOW + jnp.arange(BAND, dtype=jnp.int32)
        qpos = start + jnp.arange(Q_BLOCK, dtype=jnp.int32)
        ok = (jnp.abs(kpos[None, :] - qpos[:, None]) <= WINDOW) & (kpos[None, :] >= 0) & (kpos[None, :] < S)
        band_bias = jnp.where(ok, jnp.float32(0.0), jnp.float32(NEG_INF))
        bias = jnp.concatenate([ctx_bias, band_bias], axis=-1)
        return _softmax_attend(qi, jnp.concatenate([kc, kb], axis=1), jnp.concatenate([vc, vb], axis=1), bias, sink)

    o = lax.map(block, (qb, jnp.arange(nb, dtype=jnp.int32)))
    return jnp.moveaxis(o, 0, 1).reshape(B, S, ATT_WIDTH)


def _short_conv(u, w):
    L = u.shape[1]
    half = CONV_WIDTH // 2
    up = jnp.pad(u, ((0, 0), (half, half), (0, 0)))
    out = w[0] * up[:, 0:L]
    for j in range(1, CONV_WIDTH):
        out = out + w[j] * up[:, j:j + L]
    return out


def _multiscale_pool(u, pool_w, pool_scale):
    B, L, _ = u.shape
    ug = u.reshape(B, L, AUX_GROUPS, AUX_GROUP_DIM)
    t = jnp.arange(L, dtype=jnp.int32)
    outs = []
    for g, w in enumerate(POOL_WINDOWS):
        ui = ug[:, :, g].astype(jnp.float32)
        cs = jnp.pad(jnp.cumsum(ui, axis=1), ((0, 0), (1, 0), (0, 0)))
        lo = jnp.clip(t - w // 2, 0, L)
        hi = jnp.clip(t - w // 2 + w, 0, L)
        mean = (cs[:, hi] - cs[:, lo]) / (hi - lo).astype(jnp.float32)[None, :, None]
        outs.append((mean - ui).astype(u.dtype))
    pooled = jnp.stack(outs, axis=2)
    mixed = jnp.einsum('blgc,gcd->blgd', pooled, pool_w).reshape(B, L, AUX_WIDTH)
    return mixed * pool_scale


def _heads(t, n_heads):
    return t.reshape(t.shape[0], t.shape[1], n_heads, HEAD_DIM)


def _ctx_kv(cn, w_in, k_g):
    kv = cn @ w_in[:, ATT_WIDTH:ATT_WIDTH + 2 * KV_WIDTH]
    kc, vc = jnp.split(kv, 2, axis=-1)
    return _rms_norm(_heads(kc, ATT_KV_HEADS), k_g), _heads(vc, ATT_KV_HEADS)


def _mixer_ab(xn, cn, p, rope, need_ctx):
    B, S, _ = xn.shape
    Lc = cn.shape[1]
    q, k, v, gb, gc, u = jnp.split(xn @ p['w_in'], _split_points(IN_WIDTHS_AB), axis=-1)
    q = _apply_axial_rope(_rms_norm(_heads(q, ATT_Q_HEADS), p['q_g']), rope)
    k = _apply_axial_rope(_rms_norm(_heads(k, ATT_KV_HEADS), p['k_g']), rope)
    v = _heads(v, ATT_KV_HEADS)
    kc, vc = _ctx_kv(cn, p['w_in'], p['k_g'])
    attn = _dense_latent_attention(q, k, v, kc, vc)
    conv = gb * _short_conv(gc * u, p['conv_w'])
    y = jnp.concatenate([attn, conv], axis=-1) @ p['w_out']
    yc = None
    if need_ctx:
        qc, _, _, gbc, gcc, uc = jnp.split(cn @ p['w_in'], _split_points(IN_WIDTHS_AB), axis=-1)
        qc = _rms_norm(_heads(qc, ATT_Q_HEADS), p['q_g']).reshape(B, Lc, ATT_KV_HEADS, ATT_GROUPS, HEAD_DIM)
        attn_c = _softmax_attend(qc, kc, vc).reshape(B, Lc, ATT_WIDTH)
        conv_c = gbc * _short_conv(gcc * uc, p['conv_w'])
        yc = jnp.concatenate([attn_c, conv_c], axis=-1) @ p['w_out']
    return y, yc


def _mixer_cd(xn, cn, p, rope, need_ctx):
    B, S, _ = xn.shape
    Lc = cn.shape[1]
    sink = p['sink'].reshape(ATT_KV_HEADS, ATT_GROUPS)
    q, k, v, u = jnp.split(xn @ p['w_in'], _split_points(IN_WIDTHS_CD), axis=-1)
    q = _apply_axial_rope(_rms_norm(_heads(q, ATT_Q_HEADS), p['q_g']), rope)
    k = _apply_axial_rope(_rms_norm(_heads(k, ATT_KV_HEADS), p['k_g']), rope)
    v = _heads(v, ATT_KV_HEADS)
    kc, vc = _ctx_kv(cn, p['w_in'], p['k_g'])
    attn = _window_latent_attention(q, k, v, kc, vc, sink)
    pool = _multiscale_pool(u, p['pool_w'], p['pool_scale'])
    y = jnp.concatenate([attn, pool], axis=-1) @ p['w_out']
    yc = None
    if need_ctx:
        qc, _, _, uc = jnp.split(cn @ p['w_in'], _split_points(IN_WIDTHS_CD), axis=-1)
        qc = _rms_norm(_heads(qc, ATT_Q_HEADS), p['q_g']).reshape(B, Lc, ATT_KV_HEADS, ATT_GROUPS, HEAD_DIM)
        attn_c = _softmax_attend(qc, kc, vc, None, sink).reshape(B, Lc, ATT_WIDTH)
        pool_c = _multiscale_pool(uc, p['pool_w'], p['pool_scale'])
        yc = jnp.concatenate([attn_c, pool_c], axis=-1) @ p['w_out']
    return y, yc


def _swiglu(h, w_gate, w_up, w_down):
    return (jax.nn.silu(h @ w_gate) * (h @ w_up)) @ w_down


def setup_inputs(seed: int = 0) -> dict:
    key = jax.random.key(seed)
    keys = iter(jax.random.split(key, 64))
    f32 = jnp.float32

    def nrm(shape, scale):
        return jax.random.normal(next(keys), shape, f32) * scale

    def gain(n):
        return jnp.ones((n,), f32) + nrm((n,), 0.02)

    d_in_ab = sum(IN_WIDTHS_AB)
    d_in_cd = sum(IN_WIDTHS_CD)
    inp = {}
    inp['x'] = nrm((BATCH, SEQ, D_MODEL), 1.0)
    inp['c'] = nrm((BATCH, D_MODEL), 1.0)
    inp['ctx'] = nrm((BATCH, CTX_LEN, D_MODEL), 1.0)
    inp['c_ctx'] = nrm((D_MODEL,), 1.0)
    inp['l0_norm1_g'] = gain(D_MODEL)
    inp['l0_w_mod'] = nrm((D_MODEL, N_MOD * D_MODEL), 0.5 * D_MODEL ** -0.5)
    inp['l0_b_mod'] = nrm((N_MOD * D_MODEL,), 0.02)
    inp['l0_w_in'] = nrm((D_MODEL, d_in_ab), D_MODEL ** -0.5)
    inp['l0_q_norm_g'] = gain(HEAD_DIM)
    inp['l0_k_norm_g'] = gain(HEAD_DIM)
    inp['l0_conv_w'] = nrm((CONV_WIDTH, AUX_WIDTH), CONV_WIDTH ** -0.5)
    inp['l0_w_out'] = nrm((D_MODEL, D_MODEL), D_MODEL ** -0.5)
    inp['l0_norm2_g'] = gain(D_MODEL)
    inp['l0_w_gate'] = nrm((D_MODEL, FFN_HIDDEN), D_MODEL ** -0.5)
    inp['l0_w_up'] = nrm((D_MODEL, FFN_HIDDEN), D_MODEL ** -0.5)
    inp['l0_w_down'] = nrm((FFN_HIDDEN, D_MODEL), FFN_HIDDEN ** -0.5)
    inp['l1_norm1_g'] = gain(D_MODEL)
    inp['l1_w_mod'] = nrm((D_MODEL, N_MOD * D_MODEL), 0.5 * D_MODEL ** -0.5)
    inp['l1_b_mod'] = nrm((N_MOD * D_MODEL,), 0.02)
    inp['l1_w_in'] = nrm((D_MODEL, d_in_cd), D_MODEL ** -0.5)
    inp['l1_q_norm_g'] = gain(HEAD_DIM)
    inp['l1_k_norm_g'] = gain(HEAD_DIM)
    inp['l1_sink'] = nrm((ATT_Q_HEADS,), 0.5)
    inp['l1_pool_w'] = nrm((AUX_GROUPS, AUX_GROUP_DIM, AUX_GROUP_DIM), AUX_GROUP_DIM ** -0.5)
    inp['l1_pool_scale'] = gain(AUX_WIDTH)
    inp['l1_w_out'] = nrm((D_MODEL, D_MODEL), D_MODEL ** -0.5)
    inp['l1_norm2_g'] = gain(D_MODEL)
    inp['l1_w_gate'] = nrm((D_MODEL, FFN_HIDDEN), D_MODEL ** -0.5)
    inp['l1_w_up'] = nrm((D_MODEL, FFN_HIDDEN), D_MODEL ** -0.5)
    inp['l1_w_down'] = nrm((FFN_HIDDEN, D_MODEL), FFN_HIDDEN ** -0.5)
    inp['final_norm_g'] = gain(D_MODEL)
    return inp


def reference(x, c, ctx, c_ctx,
              l0_norm1_g, l0_w_mod, l0_b_mod, l0_w_in, l0_q_norm_g, l0_k_norm_g, l0_conv_w, l0_w_out,
              l0_norm2_g, l0_w_gate, l0_w_up, l0_w_down,
              l1_norm1_g, l1_w_mod, l1_b_mod, l1_w_in, l1_q_norm_g, l1_k_norm_g, l1_sink, l1_pool_w,
              l1_pool_scale, l1_w_out, l1_norm2_g, l1_w_gate, l1_w_up, l1_w_down,
              final_norm_g):
    layers = [
        dict(norm1_g=l0_norm1_g, w_mod=l0_w_mod, b_mod=l0_b_mod, w_in=l0_w_in, q_g=l0_q_norm_g,
             k_g=l0_k_norm_g, conv_w=l0_conv_w, w_out=l0_w_out, norm2_g=l0_norm2_g,
             w_gate=l0_w_gate, w_up=l0_w_up, w_down=l0_w_down),
        dict(norm1_g=l1_norm1_g, w_mod=l1_w_mod, b_mod=l1_b_mod, w_in=l1_w_in, q_g=l1_q_norm_g,
             k_g=l1_k_norm_g, sink=l1_sink, pool_w=l1_pool_w, pool_scale=l1_pool_scale, w_out=l1_w_out,
             norm2_g=l1_norm2_g, w_gate=l1_w_gate, w_up=l1_w_up, w_down=l1_w_down),
    ]
    rope = _axial_rope(x.shape[1])
    h = x
    hc = ctx
    sc = jax.nn.silu(c)
    sc_ctx = jax.nn.silu(c_ctx)
    for i in range(DEPTH):
        p = layers[i]
        need_ctx = i < DEPTH - 1
        shift1, scale1, gate1, shift2, scale2, gate2 = jnp.split(sc @ p['w_mod'] + p['b_mod'], N_MOD, axis=-1)
        cshift1, cscale1, cgate1, cshift2, cscale2, cgate2 = jnp.split(sc_ctx @ p['w_mod'] + p['b_mod'], N_MOD, axis=-1)
        xn = _modulate(_rms_norm(h, p['norm1_g']), shift1[:, None], scale1[:, None])
        cn = _modulate(_rms_norm(hc, p['norm1_g']), cshift1, cscale1)
        if i % 2 == 0:
            y, yc = _mixer_ab(xn, cn, p, rope, need_ctx)
        else:
            y, yc = _mixer_cd(xn, cn, p, rope, need_ctx)
        h = h + gate1[:, None] * y
        hn = _modulate(_rms_norm(h, p['norm2_g']), shift2[:, None], scale2[:, None])
        h = h + gate2[:, None] * _swiglu(hn, p['w_gate'], p['w_up'], p['w_down'])
        if need_ctx:
            hc = hc + cgate1 * yc
            hcn = _modulate(_rms_norm(hc, p['norm2_g']), cshift2, cscale2)
            hc = hc + cgate2 * _swiglu(hcn, p['w_gate'], p['w_up'], p['w_down'])
    return _rms_norm(h, final_norm_g)
```

```cpp
#include <hip/hip_runtime.h>
#include <hip/hip_cooperative_groups.h>
#include <cstdio>
#include <cstdint>
#include <cstddef>
namespace pg8 {
#define PG8_LAS __attribute__((address_space(3)))
typedef unsigned short bf16_t;
typedef short bf16x8 __attribute__((ext_vector_type(8)));
typedef float f32x4 __attribute__((ext_vector_type(4)));
typedef unsigned u32x4 __attribute__((ext_vector_type(4)));
constexpr int BM = 256, BK = 64, HALF = 128, HTB = HALF * BK * 2  , STAGE_BYTES = 8 * HTB, NXCD = 8, WGM = 8;

__host__ __device__ __forceinline__ int lds_byte(int r, int c) { const int st = (r >> 4) * 2 + (c >> 5), rr = r & 15, cc = c & 31, ob = rr * 64 + cc * 2; return st * 1024 + (ob ^ (((ob >> 9) & 1) << 5)); }
__host__ __device__ __forceinline__ void stage_rc(int b, int& R, int& C) { const int st = b / 1024, sb = b % 1024, swz = sb ^ (((sb >> 9) & 1) << 5); R = (st >> 1) * 16 + swz / 64; C = (st & 1) * 32 + (swz % 64) / 2; }
__host__ __device__ __forceinline__ int perm32(int rho) { const int n = rho >> 4, i = rho & 15; return 8 * (i >> 2) + 4 * n + (i & 3); }

struct Unit { int pm, pn, ks; };
struct Gemm { const bf16_t* A; const bf16_t* Bt; int M, N, K, ld; };

struct StaticOrder {
    int nM, nN, nwg, G, c;
    __host__ __device__ void init(int M, int N, int G_, int c_) { nM = M / BM; nN = N / BM; nwg = nM * nN; G = G_; c = c_; }
    __host__ __device__ bool next(int i, Unit& u) const {
        const long L = (long)i * G + c; if (L >= nwg) return false;
        int wgid = (int)L; { const int q = nwg / NXCD, r = nwg % NXCD, xcd = wgid % NXCD, off = wgid / NXCD; wgid = (xcd < r ? xcd * (q + 1) : r * (q + 1) + (xcd - r) * q) + off; }
        const int nig = WGM * nN, gid = wgid / nig, fm = gid * WGM, gsz = (nM - fm) < WGM ? (nM - fm) : WGM;
        u.pm = fm + ((wgid % nig) % gsz); u.pn = (wgid % nig) / gsz; u.ks = 0; return true;
    }
    __device__ __forceinline__ void a_ready(const Unit&) const {}
    __device__ __forceinline__ void done(const Unit&) const {}
};

__device__ __forceinline__ unsigned cvt_pk_bf16(float lo, float hi) { unsigned r; asm volatile("v_cvt_pk_bf16_f32 %0, %1, %2" : "=v"(r) : "v"(lo), "v"(hi)); return r; }
typedef float f32x2 __attribute__((ext_vector_type(2)));
struct EpiStoreBf16 {
    static constexpr bool PERM = true, AFTER_DRAIN = false;
    bf16_t* O; int ldc; bf16_t* VC;
    __device__ __forceinline__ void operator()(const f32x4 (&acc)[2][2][4][2], const Unit& u, int wr, int wc, int fr, int fq) const {
        const int row0 = u.pm * BM + wr * 64 + fr; const int col0 = u.pn * BM + wc * 32 + 8 * fq;
        const bool isv = (u.pn == 8 || u.pn == 9);
#pragma unroll
        for (int ai = 0; ai < 2; ++ai)
#pragma unroll
            for (int m = 0; m < 4; ++m) { const int row = row0 + ai * HALF + m * 16; bf16_t* rowp = O + (size_t)row * ldc + col0;
                if (isv) { const int b = row < 16384 ? (row >> 12) : ((row - 16384) >> 8), pos = row < 16384 ? 256 + (row & 4095) : ((row - 16384) & 255);
                    rowp = VC + ((size_t)(b * 4 + 2 * (u.pn - 8)) * 4352 + pos) * 128 + wc * 32 + 8 * fq; }
#pragma unroll
                for (int bj = 0; bj < 2; ++bj) { const f32x4 v0 = acc[ai][bj][m][0], v1 = acc[ai][bj][m][1];
                    u32x4 w; w.x = cvt_pk_bf16(v0[0], v0[1]); w.y = cvt_pk_bf16(v0[2], v0[3]); w.z = cvt_pk_bf16(v1[0], v1[1]); w.w = cvt_pk_bf16(v1[2], v1[3]);
                    *(u32x4*)(rowp + (isv ? (size_t)bj * 4352 * 128 : (size_t)bj * HALF)) = w; } }
    }
};
__device__ __forceinline__ float silu_f(float x) { return x * __builtin_amdgcn_rcpf(1.0f + __builtin_amdgcn_exp2f(-1.4426950408889634f * x)); }
struct EpiSwiGLU {
    static constexpr bool PERM = true, AFTER_DRAIN = false;
    bf16_t* O; int ldc;
    __device__ __forceinline__ void operator()(const f32x4 (&acc)[2][2][4][2], const Unit& u, int wr, int wc, int fr, int fq) const {
        const int row0 = u.pm * BM + wr * 64 + fr; const int col0 = u.pn * HALF + wc * 32 + 8 * fq;
#pragma unroll
        for (int ai = 0; ai < 2; ++ai)
#pragma unroll
            for (int m = 0; m < 4; ++m) { bf16_t* rowp = O + (size_t)(row0 + ai * HALF + m * 16) * ldc + col0;
                const f32x4 g0 = acc[ai][0][m][0], g1 = acc[ai][0][m][1], u0 = acc[ai][1][m][0], u1 = acc[ai][1][m][1];
                u32x4 w; w.x = cvt_pk_bf16(silu_f(g0[0]) * u0[0], silu_f(g0[1]) * u0[1]); w.y = cvt_pk_bf16(silu_f(g0[2]) * u0[2], silu_f(g0[3]) * u0[3]);
                w.z = cvt_pk_bf16(silu_f(g1[0]) * u1[0], silu_f(g1[1]) * u1[1]); w.w = cvt_pk_bf16(silu_f(g1[2]) * u1[2], silu_f(g1[3]) * u1[3]);
                *(u32x4*)rowp = w; }
    }
};
template <bool BASE_BF16, bool OUT_BF16>
struct EpiResGate {
    static constexpr bool PERM = true, AFTER_DRAIN = false;
    const void* base_lat; const void* base_ctx; void* out; const float* gate;
    __device__ __forceinline__ void operator()(const f32x4 (&acc)[2][2][4][2], const Unit& u, int wr, int wc, int fr, int fq) const {
        const int col0 = u.pn * BM + wc * 32 + 8 * fq; const int modrow = u.pm < 64 ? (u.pm >> 4) : 4;
        const void* base = u.pm < 64 ? base_lat : base_ctx;
        f32x4 gv[2][2];
#pragma unroll
        for (int bj = 0; bj < 2; ++bj)
#pragma unroll
            for (int n = 0; n < 2; ++n) gv[bj][n] = *(const f32x4*)(gate + modrow * 12288 + col0 + bj * HALF + 4 * n);
#pragma unroll
        for (int ai = 0; ai < 2; ++ai)
#pragma unroll
            for (int m = 0; m < 4; ++m) { const size_t off = (size_t)(u.pm * BM + ai * HALF + wr * 64 + m * 16 + fr) * 2048 + col0;
#pragma unroll
                for (int bj = 0; bj < 2; ++bj) { f32x4 b0, b1;
                    if constexpr (BASE_BF16) { const u32x4 w = *(const u32x4*)((const bf16_t*)base + off + bj * HALF);
                        b0 = (f32x4){__uint_as_float(w.x << 16), __uint_as_float(w.x & 0xffff0000u), __uint_as_float(w.y << 16), __uint_as_float(w.y & 0xffff0000u)};
                        b1 = (f32x4){__uint_as_float(w.z << 16), __uint_as_float(w.z & 0xffff0000u), __uint_as_float(w.w << 16), __uint_as_float(w.w & 0xffff0000u)}; }
                    else { b0 = *(const f32x4*)((const float*)base + off + bj * HALF); b1 = *(const f32x4*)((const float*)base + off + bj * HALF + 4); }
                    const f32x4 o0 = b0 + gv[bj][0] * acc[ai][bj][m][0], o1 = b1 + gv[bj][1] * acc[ai][bj][m][1];
                    if constexpr (OUT_BF16) { u32x4 w; w.x = cvt_pk_bf16(o0[0], o0[1]); w.y = cvt_pk_bf16(o0[2], o0[3]); w.z = cvt_pk_bf16(o1[0], o1[1]); w.w = cvt_pk_bf16(o1[2], o1[3]);
                        *(u32x4*)((bf16_t*)out + off + bj * HALF) = w; }
                    else { *(f32x4*)((float*)out + off + bj * HALF) = o0; *(f32x4*)((float*)out + off + bj * HALF + 4) = o1; } } }
    }
};
struct EpiPartF32 {
    static constexpr bool PERM = false, AFTER_DRAIN = false;
    float* out; int ldp, col0;
    __device__ __forceinline__ void operator()(const f32x4 (&acc)[2][2][4][2], const Unit& u, int wr, int wc, int fr, int fq) const {
        const int colb = u.pn * BM + wc * 32 + 4 * fq - col0;
#pragma unroll
        for (int ai = 0; ai < 2; ++ai)
#pragma unroll
            for (int m = 0; m < 4; ++m) { const size_t off = ((size_t)u.ks * 1024 + (size_t)((u.pm - 64) * BM + ai * HALF + wr * 64 + m * 16 + fr)) * ldp + colb;
#pragma unroll
                for (int bj = 0; bj < 2; ++bj)
#pragma unroll
                    for (int n = 0; n < 2; ++n) *(f32x4*)(out + off + bj * HALF + n * 16) = acc[ai][bj][m][n]; }
    }
};
struct CtxSplitOrder {
    int nks, npn, pn0, nsub, G, c;
    __device__ bool next(int i, Unit& u) const { const int L = i * G + c; if (L >= nsub) return false; u.ks = L % nks; const int t = L / nks; u.pn = pn0 + t % npn; u.pm = 64 + t / npn; return true; }
    __device__ __forceinline__ void a_ready(const Unit&) const {}
    __device__ __forceinline__ void done(const Unit&) const {}
};

template <bool BASE_BF16, int MODE>
struct EpiResNorm {
    static constexpr bool PERM = true, AFTER_DRAIN = false;
    const void* base_lat; const void* base_ctx; const float* gate;
    bf16_t* Hout; bf16_t* XNout; float* Fout;
    const float* g; const float* sc; const float* sh;
    float* ssx; unsigned* cnt;
    PG8_LAS unsigned char* xl;
    __device__ __forceinline__ void operator()(f32x4 (&acc)[2][2][4][2], const Unit& u, int wr, int wc, int fr, int fq) const {
        const int tid = threadIdx.x, lane = tid & 63;
        const int col0 = u.pn * BM + wc * 32 + 8 * fq; const int modrow = u.pm < 64 ? (u.pm >> 4) : 4;
        const void* base = u.pm < 64 ? base_lat : base_ctx;
        PG8_LAS float* P = (PG8_LAS float*)xl; PG8_LAS float* S = (PG8_LAS float*)(xl + 4096);
#pragma unroll
        for (int bj = 0; bj < 2; ++bj) { const f32x4 g0 = *(const f32x4*)(gate + modrow * 12288 + col0 + bj * HALF), g1 = *(const f32x4*)(gate + modrow * 12288 + col0 + bj * HALF + 4);
#pragma unroll
            for (int ai = 0; ai < 2; ++ai)
#pragma unroll
                for (int m = 0; m < 4; ++m) { const size_t off = (size_t)(u.pm * BM + ai * HALF + wr * 64 + m * 16 + fr) * 2048 + col0 + bj * HALF; f32x4 b0, b1;
                    if constexpr (BASE_BF16) { const u32x4 w = *(const u32x4*)((const bf16_t*)base + off);
                        b0 = (f32x4){__uint_as_float(w.x << 16), __uint_as_float(w.x & 0xffff0000u), __uint_as_float(w.y << 16), __uint_as_float(w.y & 0xffff0000u)};
                        b1 = (f32x4){__uint_as_float(w.z << 16), __uint_as_float(w.z & 0xffff0000u), __uint_as_float(w.w << 16), __uint_as_float(w.w & 0xffff0000u)}; }
                    else { b0 = *(const f32x4*)((const float*)base + off); b1 = *(const f32x4*)((const float*)base + off + 4); }
                    acc[ai][bj][m][0] = b0 + g0 * acc[ai][bj][m][0]; acc[ai][bj][m][1] = b1 + g1 * acc[ai][bj][m][1];
                    asm volatile("" : "+v"(acc[ai][bj][m][0]), "+v"(acc[ai][bj][m][1]));
                    if (m & 1) asm volatile("" ::: "memory"); } }
#pragma unroll
        for (int ai = 0; ai < 2; ++ai)
#pragma unroll
            for (int m = 0; m < 4; ++m) { float s = 0.f;
#pragma unroll
                for (int bj = 0; bj < 2; ++bj)
#pragma unroll
                    for (int n = 0; n < 2; ++n) { const f32x4 x = acc[ai][bj][m][n]; s += (x[0] * x[0] + x[1] * x[1]) + (x[2] * x[2] + x[3] * x[3]); }
                s += __shfl_xor(s, 16); s += __shfl_xor(s, 32);
                if (fq == 0) P[(ai * HALF + wr * 64 + m * 16 + fr) * 4 + wc] = s; }
        asm volatile("s_waitcnt lgkmcnt(0)" ::: "memory"); __builtin_amdgcn_s_barrier(); asm volatile("" ::: "memory");
        if (tid < 256) { const float tot = (P[tid * 4 + 0] + P[tid * 4 + 1]) + (P[tid * 4 + 2] + P[tid * 4 + 3]);
            __hip_atomic_store(ssx + ((size_t)u.pm * 256 + tid) * 8 + u.pn, tot, __ATOMIC_RELAXED, __HIP_MEMORY_SCOPE_AGENT); }
        asm volatile("s_waitcnt vmcnt(0)" ::: "memory");
        if (tid < 256 && lane == 0) __hip_atomic_fetch_add(cnt + 64 * u.pm, 1u, __ATOMIC_RELAXED, __HIP_MEMORY_SCOPE_AGENT);
        if constexpr (MODE == 0) {
#pragma unroll
            for (int bj = 0; bj < 2; ++bj)
#pragma unroll
                for (int ai = 0; ai < 2; ++ai)
#pragma unroll
                    for (int m = 0; m < 4; ++m) { const size_t off = (size_t)(u.pm * BM + ai * HALF + wr * 64 + m * 16 + fr) * 2048 + col0 + bj * HALF; const f32x4 h0 = acc[ai][bj][m][0], h1 = acc[ai][bj][m][1];
                        u32x4 w; w.x = cvt_pk_bf16(h0[0], h0[1]); w.y = cvt_pk_bf16(h0[2], h0[3]); w.z = cvt_pk_bf16(h1[0], h1[1]); w.w = cvt_pk_bf16(h1[2], h1[3]);
                        *(u32x4*)(Hout + off) = w; } }
        if (tid < 64) { unsigned sp = 0;
            while ((unsigned)__builtin_amdgcn_readfirstlane(__hip_atomic_load(cnt + 64 * u.pm, __ATOMIC_RELAXED, __HIP_MEMORY_SCOPE_AGENT)) < 32u) { __builtin_amdgcn_s_sleep(2); if (++sp > (1u << 22)) break; }
            __builtin_amdgcn_fence(__ATOMIC_ACQUIRE, "agent"); }
        asm volatile("s_waitcnt vmcnt(0) lgkmcnt(0)" ::: "memory"); __builtin_amdgcn_s_barrier(); asm volatile("" ::: "memory");
        if (tid < 256) { const float* slot = ssx + ((size_t)u.pm * 256 + tid) * 8; float q = 0.f;
#pragma unroll
            for (int t = 0; t < 8; ++t) q += __hip_atomic_load(slot + t, __ATOMIC_RELAXED, __HIP_MEMORY_SCOPE_AGENT);
            S[tid] = 1.0f / sqrtf(q * (1.0f / 2048.0f) + 1e-6f); }
        asm volatile("s_waitcnt vmcnt(0) lgkmcnt(0)" ::: "memory"); __builtin_amdgcn_s_barrier(); asm volatile("" ::: "memory");
#pragma unroll
        for (int bj = 0; bj < 2; ++bj) { const int cc = col0 + bj * HALF;
            f32x4 gs0 = *(const f32x4*)(g + cc), gs1 = *(const f32x4*)(g + cc + 4), sh0 = {0.f, 0.f, 0.f, 0.f}, sh1 = sh0;
            if constexpr (MODE == 0) { gs0 = gs0 * (1.0f + *(const f32x4*)(sc + modrow * 12288 + cc)); gs1 = gs1 * (1.0f + *(const f32x4*)(sc + modrow * 12288 + cc + 4));
                sh0 = *(const f32x4*)(sh + modrow * 12288 + cc); sh1 = *(const f32x4*)(sh + modrow * 12288 + cc + 4); }
#pragma unroll
            for (int ai = 0; ai < 2; ++ai)
#pragma unroll
                for (int m = 0; m < 4; ++m) { const int r = ai * HALF + wr * 64 + m * 16 + fr; const float rs = S[r]; const size_t off = (size_t)(u.pm * BM + r) * 2048 + cc;
                    const f32x4 h0 = acc[ai][bj][m][0], h1 = acc[ai][bj][m][1];
                    if constexpr (MODE == 0) {
                        const f32x4 y0 = h0 * rs * gs0 + sh0, y1 = h1 * rs * gs1 + sh1;
                        u32x4 x; x.x = cvt_pk_bf16(y0[0], y0[1]); x.y = cvt_pk_bf16(y0[2], y0[3]); x.z = cvt_pk_bf16(y1[0], y1[1]); x.w = cvt_pk_bf16(y1[2], y1[3]);
                        *(u32x4*)(XNout + off) = x; }
                    else { *(f32x4*)(Fout + off) = h0 * rs * gs0; *(f32x4*)(Fout + off + 4) = h1 * rs * gs1; }
                    if (m & 1) asm volatile("" ::: "memory"); } }
    }
};
struct PanelOrder {
    int nM, G, c;
    __device__ bool next(int i, Unit& u) const { const int x = c & 7, j = c >> 3; u.ks = 0;
        if (i < 2) { u.pm = i * 32 + 4 * x + (j >> 3); u.pn = j & 7; return u.pm < nM; }
        if (i == 2 && nM > 64 && c < 64 && x < 4) { u.pm = 64 + x; u.pn = j; return true; }
        return false; }
    __device__ __forceinline__ void a_ready(const Unit&) const {}
    __device__ __forceinline__ void done(const Unit&) const {}
};
template <class Epi, class Sched, bool ALIGN_EPI = false, bool SP2 = false>
__device__ __forceinline__ void gemm_phase(PG8_LAS unsigned char* lds, const Gemm g, const Sched& S, const Epi& E) {
    int tid_ = threadIdx.x; asm volatile("" : "+v"(tid_));
    const int tid = tid_, wid = __builtin_amdgcn_readfirstlane(tid >> 6), lane = tid & 63, wr = wid >> 2, wc = wid & 3, fr = lane & 15, fq = lane >> 4;
    const int K = g.ld, nt = g.K / BK;
    const size_t kslice = (size_t)g.K * 2;
    unsigned voffA[2], voffB[2];
#pragma unroll
    for (int i = 0; i < 2; ++i) { int R, C; stage_rc(tid * 16 + i * 8192, R, C); const int Rb = Epi::PERM ? ((R & ~31) + perm32(R & 31)) : R;
        voffA[i] = (unsigned)(R * K + C) * 2u; voffB[i] = (unsigned)(Rb * K + C) * 2u; }
    const size_t kstep = (size_t)(BK * 2);
    const size_t hstep = (size_t)HALF * K * 2;
    const size_t tstep = 2 * hstep;
    const unsigned ldsw = (unsigned)wid * 1024u;
    const int aoff = lds_byte(wr * 64 + fr, fq * 8), boff = lds_byte(wc * 32 + fr, fq * 8);
#define PG8_SA(b, h) (((b) * 2 + (h)) * HTB)
#define PG8_SB(b, h) ((4 + (b) * 2 + (h)) * HTB)
#define PG8_STAGE(bufoff, gbase, voff) do { _Pragma("unroll") for (int _i = 0; _i < 2; ++_i) \
        __builtin_amdgcn_global_load_lds((const unsigned*)((const char*)(gbase) + (voff)[_i]), (PG8_LAS unsigned*)(lds + (bufoff) + ldsw + _i * 8192), 16, 0, 0); } while (0)
#define PG8_LDA(dst, b, h) do { _Pragma("unroll") for (int m = 0; m < 4; ++m) _Pragma("unroll") for (int k = 0; k < 2; ++k) dst[m][k] = *(const PG8_LAS bf16x8*)(lds + PG8_SA(b, h) + aoff + m * 2048 + k * 1024); } while (0)
#define PG8_LDB(dst, b, h) do { _Pragma("unroll") for (int n = 0; n < 2; ++n) _Pragma("unroll") for (int k = 0; k < 2; ++k) dst[n][k] = *(const PG8_LAS bf16x8*)(lds + PG8_SB(b, h) + boff + n * 2048 + k * 1024); } while (0)
#define PG8_MMA(ai, bj, At, Bt) do { __builtin_amdgcn_s_setprio(1); _Pragma("unroll") for (int m = 0; m < 4; ++m) _Pragma("unroll") for (int n = 0; n < 2; ++n) _Pragma("unroll") for (int k = 0; k < 2; ++k) \
        acc[ai][bj][m][n] = __builtin_amdgcn_mfma_f32_16x16x32_bf16(Bt[n][k], At[m][k], acc[ai][bj][m][n], 0, 0, 0); __builtin_amdgcn_s_setprio(0); } while (0)
#define PG8_WAIT_V(n) asm volatile("s_waitcnt vmcnt(" #n ")" ::: "memory")
#define PG8_WAIT_L(n) asm volatile("s_waitcnt lgkmcnt(" #n ")" ::: "memory")
#define PG8_BAR __builtin_amdgcn_s_barrier()
#define PG8_SCHED __builtin_amdgcn_sched_barrier(0)
    Unit cur, nxt; int ui = 0;
    if (!S.next(0, cur)) return;
    f32x4 acc[2][2][4][2];
#pragma unroll
    for (int a = 0; a < 2; ++a)
#pragma unroll
        for (int b = 0; b < 2; ++b)
#pragma unroll
            for (int m = 0; m < 4; ++m)
#pragma unroll
                for (int n = 0; n < 2; ++n) acc[a][b][m][n] = (f32x4){0.f, 0.f, 0.f, 0.f};
    bf16x8 At[4][2], B0[2][2], B1[2][2];
    const char* cA = (const char*)g.A + (size_t)cur.pm * tstep + (size_t)cur.ks * kslice; const char* cB = (const char*)g.Bt + (size_t)cur.pn * tstep + (size_t)cur.ks * kslice;
    S.a_ready(cur);
    if constexpr (SP2) {
        PG8_STAGE(PG8_SB(0, 0), cB, voffB); PG8_STAGE(PG8_SB(0, 1), cB + hstep, voffB); PG8_STAGE(PG8_SA(0, 0), cA, voffA); PG8_STAGE(PG8_SA(0, 1), cA + hstep, voffA);
        if (wr == 1) PG8_BAR;
        PG8_WAIT_V(2); PG8_BAR;
        PG8_STAGE(PG8_SB(1, 0), cB + kstep, voffB); PG8_STAGE(PG8_SA(1, 0), cA + kstep, voffA); PG8_STAGE(PG8_SB(1, 1), cB + hstep + kstep, voffB);
        PG8_WAIT_V(6); PG8_BAR;
    } else {
        PG8_STAGE(PG8_SB(0, 0), cB, voffB); PG8_STAGE(PG8_SA(0, 0), cA, voffA); PG8_STAGE(PG8_SB(0, 1), cB + hstep, voffB); PG8_STAGE(PG8_SA(0, 1), cA + hstep, voffA);
        if (wr == 1) PG8_BAR;
        PG8_WAIT_V(4); PG8_BAR;
        PG8_STAGE(PG8_SB(1, 0), cB + kstep, voffB); PG8_STAGE(PG8_SA(1, 0), cA + kstep, voffA); PG8_STAGE(PG8_SB(1, 1), cB + hstep + kstep, voffB);
        PG8_WAIT_V(6); PG8_BAR;
    }
    for (;;) {
        const bool has_next = S.next(ui + 1, nxt);
        const char* nA = has_next ? (const char*)g.A + (size_t)nxt.pm * tstep + (size_t)nxt.ks * kslice : cA; const char* nB = has_next ? (const char*)g.Bt + (size_t)nxt.pn * tstep + (size_t)nxt.ks * kslice : cB;
        for (int t = 0; t < nt; t += 2) {
            const bool last = (t == nt - 2);
            const char* a1 = cA + (size_t)(t + 1) * kstep;
            const char* a2 = last ? nA : cA + (size_t)(t + 2) * kstep; const char* b2 = last ? nB : cB + (size_t)(t + 2) * kstep;
            const char* a3 = a2 + kstep; const char* b3 = b2 + kstep;
            if (last && has_next) S.a_ready(nxt);
            if constexpr (SP2) {
            PG8_LDB(B0, 0, 0); PG8_LDB(B1, 0, 1); PG8_SCHED; PG8_LDA(At, 0, 0); PG8_STAGE(PG8_SA(1, 1), a1 + hstep, voffA);
            PG8_WAIT_V(8); PG8_WAIT_L(0); PG8_BAR; PG8_MMA(0, 0, At, B0); PG8_MMA(0, 1, At, B1); PG8_BAR; PG8_SCHED;
            PG8_LDA(At, 0, 1); PG8_STAGE(PG8_SB(0, 0), b2, voffB); PG8_STAGE(PG8_SB(0, 1), b2 + hstep, voffB); PG8_STAGE(PG8_SA(0, 0), a2, voffA);
            PG8_WAIT_V(8); PG8_WAIT_L(0); PG8_BAR; PG8_MMA(1, 0, At, B0); PG8_MMA(1, 1, At, B1); PG8_BAR; PG8_SCHED;
            PG8_LDB(B0, 1, 0); PG8_LDB(B1, 1, 1); PG8_SCHED; PG8_LDA(At, 1, 0); PG8_STAGE(PG8_SA(0, 1), a2 + hstep, voffA);
            PG8_WAIT_V(8); PG8_WAIT_L(0); PG8_BAR; PG8_MMA(0, 0, At, B0); PG8_MMA(0, 1, At, B1); PG8_BAR; PG8_SCHED;
            PG8_LDA(At, 1, 1); PG8_STAGE(PG8_SB(1, 0), b3, voffB); PG8_STAGE(PG8_SB(1, 1), b3 + hstep, voffB); PG8_STAGE(PG8_SA(1, 0), a3, voffA);
            PG8_WAIT_V(8); PG8_WAIT_L(0); PG8_BAR; PG8_MMA(1, 0, At, B0); PG8_MMA(1, 1, At, B1); PG8_BAR; PG8_SCHED;
            } else {
            PG8_LDB(B0, 0, 0); PG8_SCHED; PG8_LDA(At, 0, 0); PG8_STAGE(PG8_SA(1, 1), a1 + hstep, voffA);
            PG8_WAIT_L(8); PG8_BAR; PG8_WAIT_L(0); PG8_MMA(0, 0, At, B0); PG8_BAR; PG8_SCHED;
            PG8_LDB(B1, 0, 1); PG8_STAGE(PG8_SB(0, 0), b2, voffB);
            PG8_BAR; PG8_WAIT_L(0); PG8_MMA(0, 1, At, B1); PG8_BAR;
            PG8_LDA(At, 0, 1); PG8_STAGE(PG8_SA(0, 0), a2, voffA);
            PG8_BAR; PG8_WAIT_L(0); PG8_MMA(1, 0, At, B0); PG8_BAR; PG8_SCHED;
            PG8_STAGE(PG8_SB(0, 1), b2 + hstep, voffB);
            PG8_WAIT_V(6); PG8_BAR; PG8_MMA(1, 1, At, B1); PG8_BAR;
            PG8_LDB(B0, 1, 0); PG8_SCHED; PG8_LDA(At, 1, 0); PG8_STAGE(PG8_SA(0, 1), a2 + hstep, voffA);
            PG8_WAIT_L(8); PG8_BAR; PG8_WAIT_L(0); PG8_MMA(0, 0, At, B0); PG8_BAR; PG8_SCHED;
            PG8_LDB(B1, 1, 1); PG8_STAGE(PG8_SB(1, 0), b3, voffB);
            PG8_BAR; PG8_WAIT_L(0); PG8_MMA(0, 1, At, B1); PG8_BAR;
            PG8_LDA(At, 1, 1); PG8_STAGE(PG8_SA(1, 0), a3, voffA);
            PG8_BAR; PG8_WAIT_L(0); PG8_MMA(1, 0, At, B0); PG8_BAR; PG8_SCHED;
            PG8_STAGE(PG8_SB(1, 1), b3 + hstep, voffB);
            PG8_WAIT_V(6); PG8_BAR; PG8_MMA(1, 1, At, B1); PG8_BAR;
            }
        }
        if constexpr (ALIGN_EPI) { if (wr == 0) PG8_BAR; }
        if constexpr (!Epi::AFTER_DRAIN) { E(acc, cur, wr, wc, fr, fq); S.done(cur); }
        if (!has_next) break;
#pragma unroll
        for (int a = 0; a < 2; ++a)
#pragma unroll
            for (int b = 0; b < 2; ++b)
#pragma unroll
                for (int m = 0; m < 4; ++m)
#pragma unroll
                    for (int n = 0; n < 2; ++n) acc[a][b][m][n] = (f32x4){0.f, 0.f, 0.f, 0.f};
        cur = nxt; cA = nA; cB = nB; ++ui;
        if constexpr (ALIGN_EPI) { if (wr == 1) PG8_BAR; }
    }
    PG8_WAIT_V(0);
    if constexpr (!ALIGN_EPI) { if (wr == 0) PG8_BAR; }
    PG8_BAR;
    if constexpr (Epi::AFTER_DRAIN) { E.fused(acc, cur, wr, wc, fr, fq, lds, wid, lane); S.done(cur); }
#undef PG8_SA
#undef PG8_SB
#undef PG8_STAGE
#undef PG8_LDA
#undef PG8_LDB
#undef PG8_MMA
#undef PG8_WAIT_V
#undef PG8_WAIT_L
#undef PG8_BAR
#undef PG8_SCHED
}
}

namespace att {
typedef unsigned short bf16_t;
using bf16x8 = __attribute__((ext_vector_type(8))) short;
using s16x4  = __attribute__((ext_vector_type(4))) short;
using f32x16 = __attribute__((ext_vector_type(16))) float;
using u32x4  = __attribute__((ext_vector_type(4))) unsigned;
constexpr int D = 128, NW = 8, QBLK = 32, KVBLK = 64;
constexpr float SCALE = 0.088388347648318440f;
constexpr float THR = 8.f;
#ifndef ATT_SDEPTH
#define ATT_SDEPTH 2
#endif
#ifndef ATT_QKB
#define ATT_QKB 1
#endif
#ifndef ATT_PVB
#define ATT_PVB 1
#endif
constexpr int SDEPTH = ATT_SDEPTH;
constexpr size_t SHM_V = KVBLK * D * 2, SHM_K = KVBLK * D * 2, SHM_ATTN = 2 * SHM_V + 2 * SHM_K + NW * 64 * 4;
#define KSWZ(row, colB) ((row) * 256 + ((colB) ^ (((row) & 7) << 4)))
#define SBAR() __builtin_amdgcn_sched_barrier(0)
__device__ __forceinline__ int crow(int r, int hi) { return (r & 3) + 8 * (r >> 2) + 4 * hi; }
__device__ __forceinline__ unsigned cvtpk(float lo, float hi) { unsigned r; asm volatile("v_cvt_pk_bf16_f32 %0, %1, %2" : "=v"(r) : "v"(lo), "v"(hi)); return r; }
__device__ __forceinline__ float bf2f(short s) { return __uint_as_float(((unsigned)(unsigned short)s) << 16); }

__device__ __forceinline__ void partialSM(f32x16& p0, f32x16& p1, float& m_reg, float& mn, float& alpha) {
  constexpr float C = SCALE * 1.4426950408889634f;
  float pmax = p0[0]; for (int r = 1; r < 16; ++r) pmax = fmaxf(pmax, p0[r]); for (int r = 0; r < 16; ++r) pmax = fmaxf(pmax, p1[r]);
  { auto rr = __builtin_amdgcn_permlane32_swap(__float_as_uint(pmax), __float_as_uint(pmax), false, false);
    pmax = fmaxf(__uint_as_float(rr[0]), __uint_as_float(rr[1])); }
  if (__builtin_expect(__all(pmax - m_reg <= THR / SCALE), 1)) { mn = m_reg; alpha = 1.f; }
  else { mn = fmaxf(m_reg, pmax); alpha = __builtin_amdgcn_exp2f((m_reg - mn) * C); m_reg = mn; }
  float mnC = -mn * C;
  for (int r = 0; r < 16; ++r) p0[r] = fmaf(p0[r], C, mnC); for (int r = 0; r < 16; ++r) p1[r] = fmaf(p1[r], C, mnC);
  for (int r = 0; r < 16; ++r) p0[r] = __builtin_amdgcn_exp2f(p0[r]);
}
__device__ __forceinline__ void smfix(f32x16& p0, f32x16& p1, float nB) {
  constexpr float C = SCALE * 1.4426950408889634f;
  for (int r = 0; r < 16; ++r) p0[r] = fmaf(p0[r], C, nB); for (int r = 0; r < 16; ++r) p1[r] = fmaf(p1[r], C, nB);
  for (int r = 0; r < 16; ++r) p0[r] = __builtin_amdgcn_exp2f(p0[r]);
}
__device__ __forceinline__ void finishSM(f32x16& p0, f32x16& p1, float alpha, float& l_reg, bf16x8& pa0, bf16x8& pa1, bf16x8& pa2, bf16x8& pa3) {
  for (int r = 0; r < 16; ++r) p1[r] = __builtin_amdgcn_exp2f(p1[r]);
  float ps = 0; for (int r = 0; r < 16; ++r) ps += p0[r]; for (int r = 0; r < 16; ++r) ps += p1[r];
  { auto rr = __builtin_amdgcn_permlane32_swap(__float_as_uint(ps), __float_as_uint(ps), false, false);
    ps = __uint_as_float(rr[0]) + __uint_as_float(rr[1]); }
  l_reg = l_reg * alpha + ps;
#define PK4(P, BASE, OUT) do { unsigned a0 = cvtpk(P[BASE + 0], P[BASE + 1]), a1 = cvtpk(P[BASE + 2], P[BASE + 3]);   \
    unsigned b0 = cvtpk(P[BASE + 4], P[BASE + 5]), b1 = cvtpk(P[BASE + 6], P[BASE + 7]);                              \
    auto r0 = __builtin_amdgcn_permlane32_swap(a0, b0, false, false); auto r1 = __builtin_amdgcn_permlane32_swap(a1, b1, false, false); \
    u32x4 w = {r0[0], r1[0], r0[1], r1[1]}; OUT = *reinterpret_cast<bf16x8*>(&w); } while (0)
  PK4(p0, 0, pa0); PK4(p0, 8, pa1); PK4(p1, 0, pa2); PK4(p1, 8, pa3);
#undef PK4
}
__device__ __forceinline__ void qkt(f32x16& p0, f32x16& p1, const char* Ks, const bf16x8* qr, int r32, int hi) {
  p0 = f32x16{}; p1 = f32x16{};
#if ATT_QKB == 1
  for (int d0 = 0; d0 < 8; ++d0) { int cb = (d0 * 16 + hi * 8) * 2;
    bf16x8 b0 = *reinterpret_cast<const bf16x8*>(Ks + KSWZ(r32, cb));
    bf16x8 b1 = *reinterpret_cast<const bf16x8*>(Ks + KSWZ(32 + r32, cb));
    p0 = __builtin_amdgcn_mfma_f32_32x32x16_bf16(b0, qr[d0], p0, 0, 0, 0);
    p1 = __builtin_amdgcn_mfma_f32_32x32x16_bf16(b1, qr[d0], p1, 0, 0, 0); }
#else
#pragma unroll
  for (int d0 = 0; d0 < 8; d0 += ATT_QKB) { bf16x8 b0[ATT_QKB], b1[ATT_QKB];
#pragma unroll
    for (int t = 0; t < ATT_QKB; ++t) { const int cb = ((d0 + t) * 16 + hi * 8) * 2;
      b0[t] = *reinterpret_cast<const bf16x8*>(Ks + KSWZ(r32, cb)); b1[t] = *reinterpret_cast<const bf16x8*>(Ks + KSWZ(32 + r32, cb)); }
    asm volatile("s_waitcnt lgkmcnt(0)" ::: "memory"); SBAR();
#pragma unroll
    for (int t = 0; t < ATT_QKB; ++t) { p0 = __builtin_amdgcn_mfma_f32_32x32x16_bf16(b0[t], qr[d0 + t], p0, 0, 0, 0); p1 = __builtin_amdgcn_mfma_f32_32x32x16_bf16(b1[t], qr[d0 + t], p1, 0, 0, 0); }
    SBAR(); }
#endif
}
__device__ __forceinline__ int v_st(int k, int c) { const int kk = (k & ~0xC) | ((k & 4) << 1) | ((k & 8) >> 1); return ((kk >> 3) * 4 + (c >> 5)) * 512 + ((kk & 7) * 32 + (c & 31)) * 2; }
__device__ __forceinline__ int v_rd_base(int lane) { return ((lane & 3) << 3) | (((lane >> 2) & 3) << 6) | (((lane >> 4) & 1) << 5) | (((lane >> 5) & 1) << 8); }
constexpr int v_rd_off(int d0, int ks, int half) { return d0 * 512 + ks * 4096 + half * 2048; }
template <int OFF> __device__ __forceinline__ s16x4 tr_read(int vb) {
  s16x4 r; asm volatile("ds_read_b64_tr_b16 %0, %1 offset:%2" : "=&v"(r) : "v"(vb), "i"(OFF) : "memory"); return r;
}
template <int D0> __device__ __forceinline__ void pv_one(f32x16& od, int vb, bf16x8 pa0, bf16x8 pa1, bf16x8 pa2, bf16x8 pa3) {
  const s16x4 l0 = tr_read<v_rd_off(D0, 0, 0)>(vb), h0 = tr_read<v_rd_off(D0, 0, 1)>(vb), l1 = tr_read<v_rd_off(D0, 1, 0)>(vb), h1 = tr_read<v_rd_off(D0, 1, 1)>(vb);
  const s16x4 l2 = tr_read<v_rd_off(D0, 2, 0)>(vb), h2 = tr_read<v_rd_off(D0, 2, 1)>(vb), l3 = tr_read<v_rd_off(D0, 3, 0)>(vb), h3 = tr_read<v_rd_off(D0, 3, 1)>(vb);
  asm volatile("s_waitcnt lgkmcnt(0)" ::: "memory"); SBAR();
#define PK(L, H) (bf16x8){L[0], L[1], L[2], L[3], H[0], H[1], H[2], H[3]}
  od = __builtin_amdgcn_mfma_f32_32x32x16_bf16(pa0, PK(l0, h0), od, 0, 0, 0);
  od = __builtin_amdgcn_mfma_f32_32x32x16_bf16(pa1, PK(l1, h1), od, 0, 0, 0);
  od = __builtin_amdgcn_mfma_f32_32x32x16_bf16(pa2, PK(l2, h2), od, 0, 0, 0);
  od = __builtin_amdgcn_mfma_f32_32x32x16_bf16(pa3, PK(l3, h3), od, 0, 0, 0);
#undef PK
}
template <int D0> __device__ __forceinline__ void pv_two(f32x16& oa, f32x16& ob, int vb, bf16x8 pa0, bf16x8 pa1, bf16x8 pa2, bf16x8 pa3) {
  const s16x4 l0 = tr_read<v_rd_off(D0, 0, 0)>(vb), h0 = tr_read<v_rd_off(D0, 0, 1)>(vb), l1 = tr_read<v_rd_off(D0, 1, 0)>(vb), h1 = tr_read<v_rd_off(D0, 1, 1)>(vb);
  const s16x4 l2 = tr_read<v_rd_off(D0, 2, 0)>(vb), h2 = tr_read<v_rd_off(D0, 2, 1)>(vb), l3 = tr_read<v_rd_off(D0, 3, 0)>(vb), h3 = tr_read<v_rd_off(D0, 3, 1)>(vb);
  const s16x4 m0 = tr_read<v_rd_off(D0 + 1, 0, 0)>(vb), g0 = tr_read<v_rd_off(D0 + 1, 0, 1)>(vb), m1 = tr_read<v_rd_off(D0 + 1, 1, 0)>(vb), g1 = tr_read<v_rd_off(D0 + 1, 1, 1)>(vb);
  const s16x4 m2 = tr_read<v_rd_off(D0 + 1, 2, 0)>(vb), g2 = tr_read<v_rd_off(D0 + 1, 2, 1)>(vb), m3 = tr_read<v_rd_off(D0 + 1, 3, 0)>(vb), g3 = tr_read<v_rd_off(D0 + 1, 3, 1)>(vb);
  asm volatile("s_waitcnt lgkmcnt(0)" ::: "memory"); SBAR();
#define PK(L, H) (bf16x8){L[0], L[1], L[2], L[3], H[0], H[1], H[2], H[3]}
  oa = __builtin_amdgcn_mfma_f32_32x32x16_bf16(pa0, PK(l0, h0), oa, 0, 0, 0);
  ob = __builtin_amdgcn_mfma_f32_32x32x16_bf16(pa0, PK(m0, g0), ob, 0, 0, 0);
  oa = __builtin_amdgcn_mfma_f32_32x32x16_bf16(pa1, PK(l1, h1), oa, 0, 0, 0);
  ob = __builtin_amdgcn_mfma_f32_32x32x16_bf16(pa1, PK(m1, g1), ob, 0, 0, 0);
  oa = __builtin_amdgcn_mfma_f32_32x32x16_bf16(pa2, PK(l2, h2), oa, 0, 0, 0);
  ob = __builtin_amdgcn_mfma_f32_32x32x16_bf16(pa2, PK(m2, g2), ob, 0, 0, 0);
  oa = __builtin_amdgcn_mfma_f32_32x32x16_bf16(pa3, PK(l3, h3), oa, 0, 0, 0);
  ob = __builtin_amdgcn_mfma_f32_32x32x16_bf16(pa3, PK(m3, g3), ob, 0, 0, 0);
#undef PK
}
__device__ __forceinline__ void pv_d0(f32x16* o, int vb, bf16x8 pa0, bf16x8 pa1, bf16x8 pa2, bf16x8 pa3) {
#if ATT_PVB == 2
  pv_two<0>(o[0], o[1], vb, pa0, pa1, pa2, pa3); pv_two<2>(o[2], o[3], vb, pa0, pa1, pa2, pa3);
#else
  pv_one<0>(o[0], vb, pa0, pa1, pa2, pa3); pv_one<1>(o[1], vb, pa0, pa1, pa2, pa3); pv_one<2>(o[2], vb, pa0, pa1, pa2, pa3); pv_one<3>(o[3], vb, pa0, pa1, pa2, pa3);
#endif
}
__device__ __forceinline__ void wmask(f32x16& p0, f32x16& p1, int kb, int qpos, int hi) {
#pragma unroll
  for (int r = 0; r < 16; ++r) { const int k0 = kb + crow(r, hi), k1 = k0 + 32;
    const bool ok0 = (unsigned)(k0 - qpos + 128) <= 256u && (unsigned)k0 < 4096u, ok1 = (unsigned)(k1 - qpos + 128) <= 256u && (unsigned)k1 < 4096u;
    p0[r] = ok0 ? p0[r] : -1e30f; p1[r] = ok1 ? p1[r] : -1e30f; }
}
struct UnitArgs {
  int qrow0;
  int qcol;
  int kvbase;
  int kstart;
  int NT;
  int tpos0;
  int rope;
  int ocol;
  float sinkl2;
  float nB;
  int has_sink;
};
template <int LDP, bool WINDOW, bool FIXED>
__device__ __forceinline__ void attn_unit(const bf16_t* __restrict__ P, const bf16_t* __restrict__ KC, const bf16_t* __restrict__ VC, bf16_t* __restrict__ CAT, const float* qg, const UnitArgs a, char* lds) {
  constexpr int SD = FIXED ? 1 : SDEPTH;
  int tid_ = threadIdx.x; asm volatile("" : "+v"(tid_));
  { __attribute__((address_space(1))) const float* qg1 = (__attribute__((address_space(1))) const float*)qg; asm volatile("" : "+s"(qg1)); qg = (const float*)qg1; }
  const int tid = tid_, wid = tid >> 6, lane = tid & 63, r32 = lane & 31, hi = lane >> 5;
  char* V_lds = lds; char* K_lds = lds + 3 * SHM_V;
  float* ws = (float*)(lds + 3 * SHM_V + 3 * SHM_K) + wid * 64; float* li_l = ws; float* al_l = ws + 32;
  float m_reg = -1e30f, l_reg = 0; f32x16 o[4] = {}; bf16x8 qr[8];
  const int qpos = a.tpos0 + wid * QBLK + r32;
  const int sr = tid >> 4, sc = (tid & 15) * 8, vst0 = v_st(sr, sc), vst1 = v_st(32 + sr, sc);
  const int vb0 = (int)(uintptr_t)V_lds + v_rd_base(lane);
  struct { bf16x8 vs0, vs1, ks0, ks1; } sr_[SD];
  const bf16_t* Kc = KC + a.kvbase + sc; const bf16_t* Vc = VC + a.kvbase + sc;
#define TROW(jt) ((jt) < 4 ? 64 * (jt) : max(256 + a.kstart + 64 * ((jt) - 4), 0))
#define SLOAD(i, jt) do { const size_t _r0 = (size_t)(TROW(jt) + sr) * 128; const size_t _r1 = _r0 + (size_t)32 * 128; \
    sr_[i].vs0 = *reinterpret_cast<const bf16x8*>(Vc + _r0); sr_[i].vs1 = *reinterpret_cast<const bf16x8*>(Vc + _r1); \
    sr_[i].ks0 = *reinterpret_cast<const bf16x8*>(Kc + _r0); sr_[i].ks1 = *reinterpret_cast<const bf16x8*>(Kc + _r1); } while (0)
  SLOAD(0, 0);
  {
    const bf16_t* Qw = P + (size_t)(a.qrow0 + wid * QBLK + r32) * LDP + a.qcol + hi * 8;
    bf16x8 raw[8];
#pragma unroll
    for (int d0 = 0; d0 < 8; ++d0) raw[d0] = *reinterpret_cast<const bf16x8*>(Qw + d0 * 16);
    float ss = 0.f;
#pragma unroll
    for (int d0 = 0; d0 < 8; ++d0)
#pragma unroll
      for (int e = 0; e < 8; ++e) { const float f = bf2f(raw[d0][e]); ss += f * f; }
    { auto rr = __builtin_amdgcn_permlane32_swap(__float_as_uint(ss), __float_as_uint(ss), false, false); ss = __uint_as_float(rr[0]) + __uint_as_float(rr[1]); }
    const float rstd = 1.0f / sqrtf(ss * (1.0f / 128.0f) + 1e-6f);
    const float pr = (float)(qpos >> 6), pc = (float)(qpos & 63);
#pragma unroll
    for (int ax = 0; ax < 2; ++ax)
#pragma unroll
      for (int dd = 0; dd < 2; ++dd) { const int da = ax * 4 + dd, db = da + 2; float x1[8], x2[8];
        const float* ga = qg + da * 16 + hi * 8; const float* gb = qg + db * 16 + hi * 8;
#pragma unroll
        for (int e = 0; e < 8; ++e) { x1[e] = bf2f(raw[da][e]) * rstd * ga[e]; x2[e] = bf2f(raw[db][e]) * rstd * gb[e]; }
        if (a.rope) { const float pos = ax == 0 ? pr : pc;
#pragma unroll
          for (int e = 0; e < 8; ++e) { const int i = dd * 16 + hi * 8 + e; const float inv = __builtin_amdgcn_exp2f(-(float)i * 0.41524101186092029f);
            const float an = pos * inv, c = __cosf(an), s = __sinf(an), y1 = x1[e] * c - x2[e] * s, y2 = x2[e] * c + x1[e] * s; x1[e] = y1; x2[e] = y2; } }
        { u32x4 w = {cvtpk(x1[0], x1[1]), cvtpk(x1[2], x1[3]), cvtpk(x1[4], x1[5]), cvtpk(x1[6], x1[7])}; qr[da] = *reinterpret_cast<bf16x8*>(&w); }
        { u32x4 w = {cvtpk(x2[0], x2[1]), cvtpk(x2[2], x2[3]), cvtpk(x2[4], x2[5]), cvtpk(x2[6], x2[7])}; qr[db] = *reinterpret_cast<bf16x8*>(&w); }
        asm volatile("" ::: "memory"); }
  }
#define SWRITE(b, i) do { *(bf16x8*)(V_lds + (b) * SHM_V + vst0) = sr_[i].vs0;          \
    *(bf16x8*)(V_lds + (b) * SHM_V + vst1) = sr_[i].vs1; int kc = sc * 2;               \
    *(bf16x8*)(K_lds + (b) * SHM_K + KSWZ(sr, kc)) = sr_[i].ks0;                       \
    *(bf16x8*)(K_lds + (b) * SHM_K + KSWZ(32 + sr, kc)) = sr_[i].ks1; } while (0)
#define SWAIT() do { if constexpr (SD == 2) asm volatile("s_waitcnt vmcnt(4)" ::: "memory"); else asm volatile("s_waitcnt vmcnt(0)" ::: "memory"); } while (0)
#define RESC(al) do { if (__any((al) < 1.f)) { if (hi == 0) al_l[r32] = (al); asm volatile("s_waitcnt lgkmcnt(0)" ::: "memory"); \
    for (int d = 0; d < 4; ++d) for (int r = 0; r < 16; ++r) o[d][r] *= al_l[crow(r, hi)]; } } while (0)
#define WMASK(p0, p1, jt) do { if constexpr (WINDOW) { if ((jt) >= 4) wmask(p0, p1, a.kstart + 64 * ((jt) - 4), qpos, hi); } } while (0)
#define PSM(q0, q1, mnx, alx) do { if constexpr (FIXED) { smfix(q0, q1, a.nB); alx = 1.f; } else partialSM(q0, q1, m_reg, mnx, alx); } while (0)
  f32x16 pA0, pA1, pB0, pB1; float mnA, mnB, alA, alB; bf16x8 pa0, pa1, pa2, pa3; const int NT = a.NT;
  constexpr int SE = 0, SO = SD - 1;
  asm volatile("s_waitcnt vmcnt(0)" ::: "memory"); SWRITE(0, SE); __syncthreads();
  qkt(pA0, pA1, K_lds, qr, r32, hi); PSM(pA0, pA1, mnA, alA);
  SLOAD(SO, 1); if constexpr (SD == 2) { if (2 < NT) SLOAD(SE, 2); }
  SWAIT(); SWRITE(1, SO); __syncthreads();
  int bprev = 0, bcur = 1, bnext = 2;
#define ROT() do { bprev = bcur; bcur = bnext; bnext = (bnext == 2) ? 0 : bnext + 1; } while (0)
  for (int j = 1; j + 1 < NT; j += 2) {
    SBAR(); qkt(pB0, pB1, K_lds + bcur * (int)SHM_K, qr, r32, hi);
    finishSM(pA0, pA1, alA, l_reg, pa0, pa1, pa2, pa3); SBAR();
    SLOAD(SO, j + SD); SBAR();
    pv_d0(o, vb0 + bprev * (int)SHM_V, pa0, pa1, pa2, pa3); WMASK(pB0, pB1, j); PSM(pB0, pB1, mnB, alB);
    SWAIT(); SWRITE(bnext, SE);
    if constexpr (!FIXED) RESC(alB); __syncthreads(); ROT();
    SBAR(); qkt(pA0, pA1, K_lds + bcur * (int)SHM_K, qr, r32, hi);
    finishSM(pB0, pB1, alB, l_reg, pa0, pa1, pa2, pa3); SBAR();
    if (SD == 1 || j + 3 < NT) SLOAD(SE, j + 1 + SD); SBAR();
    pv_d0(o, vb0 + bprev * (int)SHM_V, pa0, pa1, pa2, pa3); WMASK(pA0, pA1, j + 1); PSM(pA0, pA1, mnA, alA);
    SWAIT(); SWRITE(bnext, SO);
    if constexpr (!FIXED) RESC(alA); __syncthreads(); ROT();
  }
  SBAR(); qkt(pB0, pB1, K_lds + bcur * (int)SHM_K, qr, r32, hi);
  finishSM(pA0, pA1, alA, l_reg, pa0, pa1, pa2, pa3); SBAR();
  pv_d0(o, vb0 + bprev * (int)SHM_V, pa0, pa1, pa2, pa3); WMASK(pB0, pB1, NT - 1); PSM(pB0, pB1, mnB, alB);
  if constexpr (!FIXED) RESC(alB);
  finishSM(pB0, pB1, alB, l_reg, pa0, pa1, pa2, pa3); SBAR();
  pv_d0(o, vb0 + bcur * (int)SHM_V, pa0, pa1, pa2, pa3);
#undef ROT
  if (a.has_sink) l_reg += __builtin_amdgcn_exp2f(FIXED ? a.sinkl2 + a.nB : a.sinkl2 - m_reg * (SCALE * 1.4426950408889634f));
#undef PSM
  if (hi == 0) li_l[r32] = l_reg; asm volatile("s_waitcnt lgkmcnt(0)" ::: "memory");
  float rli[16];
#pragma unroll
  for (int r = 0; r < 16; ++r) rli[r] = __builtin_amdgcn_rcpf(li_l[crow(r, hi)]);
  bf16_t* Ow = CAT + (size_t)(a.qrow0 + wid * QBLK) * 2048 + a.ocol + r32;
#pragma unroll
  for (int r = 0; r < 16; ++r) { const int orow = crow(r, hi);
#pragma unroll
    for (int d0 = 0; d0 < 4; ++d0) { const float v = o[d0][r] * rli[r]; Ow[(size_t)orow * 2048 + d0 * 32] = (bf16_t)(cvtpk(v, v) & 0xffffu); } }
#undef TROW
#undef SLOAD
#undef SWRITE
#undef SWAIT
#undef RESC
#undef WMASK
}
}

namespace cg = cooperative_groups;
typedef unsigned short bf16_t;
typedef float f32x4 __attribute__((ext_vector_type(4)));
typedef float f32x2 __attribute__((ext_vector_type(2)));
typedef unsigned u32x4 __attribute__((ext_vector_type(4)));
typedef unsigned u32x2 __attribute__((ext_vector_type(2)));
typedef short bf16x8 __attribute__((ext_vector_type(8)));
typedef short s16x4 __attribute__((ext_vector_type(4)));

constexpr int DM = 2048, SEQ = 4096, NB = 4, CTXL = 256, FFN = 5632, NMOD = 12288;
constexpr int MLAT = NB * SEQ, MCTX = NB * CTXL, MALL = MLAT + MCTX;
constexpr int LDP0 = 4096, LDP1 = 3072;
constexpr float EPS = 1e-6f;
constexpr size_t MiB = 1u << 20;
constexpr size_t WS_BAR = 512 * 1024, BAR_BYTES = 16384, WS_CNT = 640 * 1024, WS_CNTX = 768 * 1024, ZERO_BYTES = 1u << 20;
constexpr size_t WS_MOD = 0, WS_W0IN = 1 * MiB, WS_W0OUT = 17 * MiB, WS_W0GU = 25 * MiB, WS_W0DN = 69 * MiB, WS_W1IN = 91 * MiB, WS_W1OUT = 103 * MiB, WS_W1GU = 111 * MiB, WS_W1DN = 155 * MiB;
constexpr size_t WS_XN = 177 * MiB, WS_H = 245 * MiB, WS_PROJ = 381 * MiB, WS_CAT = 517 * MiB, WS_HID = WS_PROJ, WS_PP = 585 * MiB, WS_KC = 617 * MiB, WS_VC = 634 * MiB, WS_SSX = 652 * MiB, WS_END = 656 * MiB;
static_assert(WS_HID + (size_t)MALL * FFN * 2 <= WS_END && WS_CAT + (size_t)MALL * DM * 2 <= WS_END && WS_PROJ + (size_t)MALL * LDP0 * 2 <= WS_CAT, "ws map");
constexpr int NWAVES = 8, NTHR = 512;
constexpr int LDS_BYTES = 147456;

#define LAS __attribute__((address_space(3)))
#define XB_TMO      128
#define XB_XCNT(j)  (256  + 64 * (j))
#define XB_XSUB(j)  (1280 + 64 * (j))
#define XB_XGEN(j)  (2304 + 64 * (j))
#define XB_TOP      3328
#define XB_TOPGEN   3392
#define XCD_BAR_WORDS 3456
#define XB_SPIN_CAP (1u << 18)

__device__ __forceinline__ unsigned xb_ld(unsigned* p)              { return __hip_atomic_load(p, __ATOMIC_RELAXED, __HIP_MEMORY_SCOPE_AGENT); }
__device__ __forceinline__ unsigned xb_add(unsigned* p, unsigned v) { return __hip_atomic_fetch_add(p, v, __ATOMIC_RELAXED, __HIP_MEMORY_SCOPE_AGENT); }
__device__ __forceinline__ unsigned xb_xcc_id() { return (unsigned)__builtin_amdgcn_s_getreg((3 << 11) | 20) & 0xFu; }
#define XB_SPIN(cond, bar) do { unsigned _sp = 0; while (cond) { __builtin_amdgcn_s_sleep(1); \
    if ((++_sp & 255u) == 0u) { if (xb_ld(&(bar)[XB_TMO])) break; if (_sp > XB_SPIN_CAP) { atomicAdd(&(bar)[XB_TMO], 1u); break; } } } } while (0)

struct XcdBarrier {
    unsigned* bar; unsigned x;
    volatile LAS unsigned* st;
};

__device__ __forceinline__ XcdBarrier xcd_barrier_post(unsigned* bar, volatile LAS unsigned* st) {
    XcdBarrier b; b.bar = bar; b.x = xb_xcc_id(); b.st = st;
    if (threadIdx.x == 0) (void)xb_add(&bar[XB_XCNT(b.x)], 1u);
    return b;
}
__device__ __forceinline__ void xcd_barrier_complete(unsigned* bar, unsigned x, unsigned& nloc, unsigned& nx) {
    const unsigned G = gridDim.x * gridDim.y * gridDim.z;
    unsigned sum, cnt, mine, sp = 0u;
    for (;;) {
        sum = 0u; cnt = 0u; mine = 0u;
#pragma unroll
        for (unsigned j = 0; j < 16; ++j) { const unsigned c = xb_ld(&bar[XB_XCNT(j)]); sum += c; cnt += (c > 0u) ? 1u : 0u; mine = (j == x) ? c : mine; }
        if (sum == G) break;
        __builtin_amdgcn_s_sleep(1);
        if ((++sp & 255u) == 0u) { if (xb_ld(&bar[XB_TMO])) break; if (sp > XB_SPIN_CAP) { atomicAdd(&bar[XB_TMO], 1u); break; } }
    }
    nloc = mine > 0u ? mine : 1u; nx = cnt > 0u ? cnt : 1u;
}

__device__ __forceinline__ void xcd_barrier(const XcdBarrier& b) {
    asm volatile("s_waitcnt vmcnt(0)" ::: "memory");
    __syncthreads();
    if (threadIdx.x == 0) {
        unsigned* bar; { __attribute__((address_space(1))) unsigned* b1 = (__attribute__((address_space(1))) unsigned*)b.bar; asm volatile("" : "+s"(b1)); bar = (unsigned*)b1; }
        __builtin_amdgcn_s_waitcnt(0);
        unsigned nloc = b.st[0], nx = b.st[1];
        if (nloc == 0u) { unsigned bx0 = b.x; asm volatile("" : "+s"(bx0)); xcd_barrier_complete(bar, bx0, nloc, nx); b.st[0] = nloc; b.st[1] = nx; }
        unsigned bx = b.x; asm volatile("" : "+s"(bx));
        const unsigned old = xb_add(&bar[XB_XSUB(bx)], 1u);
        const unsigned gen = old / nloc;
        if (old + 1u == (gen + 1u) * nloc) {
            __builtin_amdgcn_fence(__ATOMIC_RELEASE, "agent");
            asm volatile("s_waitcnt vmcnt(0)" ::: "memory");
            const unsigned og = xb_add(&bar[XB_TOP], 1u);
            const unsigned tg = og / nx;
            if (og + 1u == (tg + 1u) * nx) xb_add(&bar[XB_TOPGEN], 1u);
            else XB_SPIN(xb_ld(&bar[XB_TOPGEN]) == tg, bar);
            __builtin_amdgcn_fence(__ATOMIC_ACQUIRE, "agent");
            xb_add(&bar[XB_XGEN(bx)], 1u);
            asm volatile("s_waitcnt vmcnt(0)" ::: "memory");
        } else {
            XB_SPIN(xb_ld(&bar[XB_XGEN(bx)]) == gen, bar);
            __builtin_amdgcn_fence(__ATOMIC_ACQUIRE, "agent");
            asm volatile("s_waitcnt vmcnt(0)" ::: "memory");
        }
    }
    __syncthreads();
}

struct Args {
  const float *x, *c, *ctx, *c_ctx;
  const float *l0_norm1_g, *l0_w_mod, *l0_b_mod, *l0_w_in, *l0_q_g, *l0_k_g, *l0_conv_w, *l0_w_out, *l0_norm2_g, *l0_w_gate, *l0_w_up, *l0_w_down;
  const float *l1_norm1_g, *l1_w_mod, *l1_b_mod, *l1_w_in, *l1_q_g, *l1_k_g, *l1_sink, *l1_pool_w, *l1_pool_scale, *l1_w_out, *l1_norm2_g, *l1_w_gate, *l1_w_up, *l1_w_down;
  const float *final_g;
  float* out; unsigned char* ws;
};

__device__ __forceinline__ float wave_sum(float v) {
#pragma unroll
  for (int o = 1; o < 64; o <<= 1) v += __shfl_xor(v, o);
  return v;
}
__device__ __forceinline__ unsigned pk2(float lo, float hi) { return pg8::cvt_pk_bf16(lo, hi); }
__device__ __forceinline__ float bf2f(unsigned short s) { return __uint_as_float(((unsigned)s) << 16); }
__device__ __forceinline__ float silu(float x) { return x / (1.0f + __expf(-x)); }

template <int MODE>
__device__ __forceinline__ void tr_item(const float* __restrict__ W, int N, bf16_t* __restrict__ WT, int ldk, int item, int lane, unsigned char* ldsw) {
  const int nblk = N >> 6, kb = item / nblk, nb = item - kb * nblk, k0 = kb * 64, n0 = nb * 64;
  const float* src = W + (size_t)k0 * N + n0 + lane;
  float v[64];
#pragma unroll
  for (int i = 0; i < 64; ++i) v[i] = __builtin_nontemporal_load(src + (size_t)i * N);
#pragma unroll
  for (int c = 0; c < 8; ++c) { u32x4 w; w.x = pk2(v[8 * c], v[8 * c + 1]); w.y = pk2(v[8 * c + 2], v[8 * c + 3]); w.z = pk2(v[8 * c + 4], v[8 * c + 5]); w.w = pk2(v[8 * c + 6], v[8 * c + 7]);
    *(u32x4*)(ldsw + lane * 144 + c * 16) = w; }
  const int rr = lane >> 3, ch = lane & 7;
#pragma unroll
  for (int j = 0; j < 8; ++j) { const int r = 8 * j + rr, n = n0 + r; const int drow = MODE == 0 ? n : ((n >> 7) * 256 + (n & 127) + (MODE == 2 ? 128 : 0));
    const u32x4 w = *(const u32x4*)(ldsw + r * 144 + ch * 16);
    *(u32x4*)(WT + (size_t)drow * ldk + k0 + ch * 8) = w; }
}

template <bool PART, bool SRC_BF16>
__device__ __forceinline__ void norm_mod_rows(const void* __restrict__ src_lat, const void* __restrict__ src_ctx, int nrows, const float* __restrict__ g, const float* __restrict__ mod, int so, int sco,
                                              bf16_t* __restrict__ XN, int gw, int ngw, int lane, const float* __restrict__ part = nullptr, const float* __restrict__ pgate = nullptr, int row0 = 0) {
  asm volatile("" : "+v"(lane));
  for (int row = row0 + gw; row < nrows; row += ngw) {
    const size_t xoff = row < MLAT ? (size_t)row * DM : (size_t)(row - MLAT) * DM; const void* xb = row < MLAT ? src_lat : src_ctx;
    const float* mr = mod + (row < MLAT ? (row >> 12) : 4) * NMOD;
    f32x4 v[8]; float ss = 0.f;
#pragma unroll
    for (int j = 0; j < 8; ++j) {
      if constexpr (SRC_BF16) { const u32x2 w = ((const u32x2*)((const bf16_t*)xb + xoff))[lane + 64 * j]; v[j] = (f32x4){__uint_as_float(w.x << 16), __uint_as_float(w.x & 0xffff0000u), __uint_as_float(w.y << 16), __uint_as_float(w.y & 0xffff0000u)}; }
      else v[j] = ((const f32x4*)((const float*)xb + xoff))[lane + 64 * j];
      if (PART && row >= MLAT) { const float* pr = part + (size_t)(row - MLAT) * DM + 4 * (lane + 64 * j); const f32x4 ps = (*(const f32x4*)pr + *(const f32x4*)(pr + (size_t)1024 * DM)) + (*(const f32x4*)(pr + (size_t)2048 * DM) + *(const f32x4*)(pr + (size_t)3072 * DM));
        v[j] += *(const f32x4*)(pgate + 4 * (lane + 64 * j)) * ps; }
      ss += (v[j].x * v[j].x + v[j].y * v[j].y) + (v[j].z * v[j].z + v[j].w * v[j].w); }
    const float rstd = 1.0f / sqrtf(wave_sum(ss) * (1.0f / DM) + EPS);
    u32x2* o8 = (u32x2*)(XN + (size_t)row * DM) + lane;
#pragma unroll
    for (int j = 0; j < 8; ++j) { const int col = 4 * (lane + 64 * j); const f32x4 gg = *(const f32x4*)(g + col), sc = *(const f32x4*)(mr + sco + col), sh = *(const f32x4*)(mr + so + col);
      const f32x4 y = v[j] * rstd * gg * (1.0f + sc) + sh; u32x2 w; w.x = pk2(y.x, y.y); w.y = pk2(y.z, y.w); o8[64 * j] = w; }
  }
}
__device__ __forceinline__ void final_norm_rows(const float* H, const float* __restrict__ g, float* out, int gw, int ngw, int lane) {
  asm volatile("" : "+v"(lane));
  for (int row = gw; row < MLAT; row += ngw) {
    const float* xr = H + (size_t)row * DM; f32x4 v[8]; float ss = 0.f;
#pragma unroll
    for (int j = 0; j < 8; ++j) { v[j] = ((const f32x4*)xr)[lane + 64 * j]; ss += (v[j].x * v[j].x + v[j].y * v[j].y) + (v[j].z * v[j].z + v[j].w * v[j].w); }
    const float rstd = 1.0f / sqrtf(wave_sum(ss) * (1.0f / DM) + EPS);
    f32x4* o = (f32x4*)(out + (size_t)row * DM) + lane;
#pragma unroll
    for (int j = 0; j < 8; ++j) { const f32x4 gg = *(const f32x4*)(g + 4 * (lane + 64 * j)); o[64 * j] = v[j] * rstd * gg; }
  }
}
template <int LDP>
__device__ __forceinline__ void knorm_row(const bf16_t* __restrict__ P, bf16_t* __restrict__ KC, bf16_t* __restrict__ VC, int row, const float* __restrict__ kg, int lane) {
  const int head = lane >> 4, s = lane & 15, half = s >> 3, i4 = (s & 7) * 4, d1 = half * 64 + i4;
  const bf16_t* p = P + (size_t)row * LDP + 1536 + head * 128 + d1;
  const int kb = row < MLAT ? (row >> 12) : ((row - MLAT) >> 8), kpos = row < MLAT ? 256 + (row & (SEQ - 1)) : ((row - MLAT) & (CTXL - 1));
  const size_t kvo = ((size_t)(kb * 4 + head) * 4352 + kpos) * 128;
  const u32x2 a = *(const u32x2*)p, b = *(const u32x2*)(p + 32);
  float x1[4] = {__uint_as_float(a.x << 16), __uint_as_float(a.x & 0xffff0000u), __uint_as_float(a.y << 16), __uint_as_float(a.y & 0xffff0000u)};
  float x2[4] = {__uint_as_float(b.x << 16), __uint_as_float(b.x & 0xffff0000u), __uint_as_float(b.y << 16), __uint_as_float(b.y & 0xffff0000u)};
  float ss = 0.f;
#pragma unroll
  for (int e = 0; e < 4; ++e) ss += x1[e] * x1[e] + x2[e] * x2[e];
  ss += __shfl_xor(ss, 1); ss += __shfl_xor(ss, 2); ss += __shfl_xor(ss, 4); ss += __shfl_xor(ss, 8);
  const float rstd = 1.0f / sqrtf(ss * (1.0f / 128.0f) + EPS);
  const f32x4 g1 = *(const f32x4*)(kg + d1), g2 = *(const f32x4*)(kg + d1 + 32);
#pragma unroll
  for (int e = 0; e < 4; ++e) { x1[e] *= rstd * g1[e]; x2[e] *= rstd * g2[e]; }
  if (row < MLAT) {
    const int t = row & (SEQ - 1); const float pos = (float)(half == 0 ? (t >> 6) : (t & 63));
#pragma unroll
    for (int e = 0; e < 4; ++e) { const float inv = __builtin_amdgcn_exp2f(-(float)(i4 + e) * 0.41524101186092029f), an = pos * inv, c = __cosf(an), sn = __sinf(an);
      const float y1 = x1[e] * c - x2[e] * sn, y2 = x2[e] * c + x1[e] * sn; x1[e] = y1; x2[e] = y2; }
  }
  u32x2 oa, ob; oa.x = pk2(x1[0], x1[1]); oa.y = pk2(x1[2], x1[3]); ob.x = pk2(x2[0], x2[1]); ob.y = pk2(x2[2], x2[3]);
  *(u32x2*)(KC + kvo + d1) = oa; *(u32x2*)(KC + kvo + d1 + 32) = ob;
}
__device__ __forceinline__ void kv_ctx_from_part(const float* __restrict__ part, bf16_t* __restrict__ KC, bf16_t* __restrict__ VC, int row, const float* __restrict__ kg, int lane) {
  const int r = row - MLAT, head = lane >> 4, s = lane & 15, half = s >> 3, i4 = (s & 7) * 4, d1 = half * 64 + i4;
  const float* pk = part + (size_t)r * 1024 + head * 128 + d1; const float* pv = part + (size_t)r * 1024 + 512 + lane * 8;
  f32x4 x1 = {0.f, 0.f, 0.f, 0.f}, x2 = x1, v0 = x1, v1 = x1;
#pragma unroll
  for (int ks = 0; ks < 8; ++ks) { const size_t o = (size_t)ks * 1024 * 1024; x1 += *(const f32x4*)(pk + o); x2 += *(const f32x4*)(pk + o + 32); v0 += *(const f32x4*)(pv + o); v1 += *(const f32x4*)(pv + o + 4); }
  float ss = (x1.x * x1.x + x1.y * x1.y) + (x1.z * x1.z + x1.w * x1.w) + (x2.x * x2.x + x2.y * x2.y) + (x2.z * x2.z + x2.w * x2.w);
  ss += __shfl_xor(ss, 1); ss += __shfl_xor(ss, 2); ss += __shfl_xor(ss, 4); ss += __shfl_xor(ss, 8);
  const float rstd = 1.0f / sqrtf(ss * (1.0f / 128.0f) + EPS);
  x1 = x1 * rstd * *(const f32x4*)(kg + d1); x2 = x2 * rstd * *(const f32x4*)(kg + d1 + 32);
  const size_t kvo = ((size_t)((r >> 8) * 4 + head) * 4352 + (r & (CTXL - 1))) * 128;
  u32x2 oa, ob; oa.x = pk2(x1.x, x1.y); oa.y = pk2(x1.z, x1.w); ob.x = pk2(x2.x, x2.y); ob.y = pk2(x2.z, x2.w);
  *(u32x2*)(KC + kvo + d1) = oa; *(u32x2*)(KC + kvo + d1 + 32) = ob;
  u32x4 w; w.x = pk2(v0.x, v0.y); w.y = pk2(v0.z, v0.w); w.z = pk2(v1.x, v1.y); w.w = pk2(v1.z, v1.w);
  *(u32x4*)(VC + kvo + (lane & 15) * 8) = w;
}
__device__ __forceinline__ void bf8_to_f(const u32x4 w, float* f) {
  f[0] = __uint_as_float(w.x << 16); f[1] = __uint_as_float(w.x & 0xffff0000u); f[2] = __uint_as_float(w.y << 16); f[3] = __uint_as_float(w.y & 0xffff0000u);
  f[4] = __uint_as_float(w.z << 16); f[5] = __uint_as_float(w.z & 0xffff0000u); f[6] = __uint_as_float(w.w << 16); f[7] = __uint_as_float(w.w & 0xffff0000u);
}
__device__ __forceinline__ void conv_row(const bf16_t* __restrict__ P, bf16_t* __restrict__ CAT, int row, const float* __restrict__ cw, int lane) {
  int t, L; if (row < MLAT) { t = row & (SEQ - 1); L = SEQ; } else { t = (row - MLAT) & (CTXL - 1); L = CTXL; }
  const int c8 = lane * 8; const bf16_t* p = P + (size_t)row * LDP0 + c8;
  float gb[8], acc[8];
  bf8_to_f(*(const u32x4*)(p + 2560), gb);
#pragma unroll
  for (int e = 0; e < 8; ++e) acc[e] = 0.f;
#pragma unroll
  for (int j = 0; j < 3; ++j) { const int tt = t + j - 1; if (tt >= 0 && tt < L) { const bf16_t* q = p + (ptrdiff_t)(j - 1) * LDP0; float gc[8], u[8]; bf8_to_f(*(const u32x4*)(q + 3072), gc); bf8_to_f(*(const u32x4*)(q + 3584), u);
      const f32x4 w0 = *(const f32x4*)(cw + j * 512 + c8), w1 = *(const f32x4*)(cw + j * 512 + c8 + 4);
#pragma unroll
      for (int e = 0; e < 4; ++e) { acc[e] += w0[e] * (gc[e] * u[e]); acc[4 + e] += w1[e] * (gc[4 + e] * u[4 + e]); } } }
  u32x4 w; w.x = pk2(gb[0] * acc[0], gb[1] * acc[1]); w.y = pk2(gb[2] * acc[2], gb[3] * acc[3]); w.z = pk2(gb[4] * acc[4], gb[5] * acc[5]); w.w = pk2(gb[6] * acc[6], gb[7] * acc[7]);
  *(u32x4*)(CAT + (size_t)row * DM + 1536 + c8) = w;
}
__device__ __forceinline__ void pool_row(const bf16_t* __restrict__ P, bf16_t* __restrict__ CAT, int row, int lane) {
  const int t = row & (SEQ - 1), c8 = lane * 8, hw = 1 << (lane >> 4);
  const int lo = max(t - hw, 0), hi = min(t + hw, SEQ);
  const bf16_t* p = P + (size_t)row * LDP1 + 2560 + c8;
  float acc[8], f[8];
#pragma unroll
  for (int e = 0; e < 8; ++e) acc[e] = 0.f;
  for (int j = -8; j < 8; ++j) { const int tt = t + j; if (tt >= lo && tt < hi) { bf8_to_f(*(const u32x4*)(p + (ptrdiff_t)j * LDP1), f);
#pragma unroll
      for (int e = 0; e < 8; ++e) acc[e] += f[e]; } }
  bf8_to_f(*(const u32x4*)p, f);
  const float rn = 1.0f / (float)(hi - lo);
  u32x4 w; w.x = pk2(acc[0] * rn - f[0], acc[1] * rn - f[1]); w.y = pk2(acc[2] * rn - f[2], acc[3] * rn - f[3]); w.z = pk2(acc[4] * rn - f[4], acc[5] * rn - f[5]); w.w = pk2(acc[6] * rn - f[6], acc[7] * rn - f[7]);
  *(u32x4*)(CAT + (size_t)row * DM + 1536 + c8) = w;
}


template <int ROWS = 64>
__device__ __forceinline__ void mod_item(const float* __restrict__ Wm, const float* __restrict__ bm, const float* __restrict__ cc, const float* __restrict__ cctx, float* __restrict__ MODl, int item, unsigned char* lds) {
  int tid = threadIdx.x; asm volatile("" : "+v"(tid));
  const int lane = tid & 63, wave = __builtin_amdgcn_readfirstlane(tid >> 6), kc = item & (2048 / ROWS - 1), cb = item / (2048 / ROWS), k0 = kc * ROWS, col = cb * 2048 + wave * 256 + lane * 4;
  float* S = (float*)lds;
  if (tid < 5 * ROWS) { const int r = tid / ROWS, k = k0 + (tid % ROWS); S[tid] = silu(r < 4 ? cc[r * 2048 + k] : cctx[k]); }
  __syncthreads();
  f32x4 acc[5];
#pragma unroll
  for (int r = 0; r < 5; ++r) acc[r] = (f32x4){0.f, 0.f, 0.f, 0.f};
  const float* wp = Wm + (size_t)k0 * NMOD + col;
#pragma unroll 1
  for (int k = 0; k < ROWS; k += 16) { f32x4 w[16];
#pragma unroll
    for (int i = 0; i < 16; ++i) w[i] = __builtin_nontemporal_load((const f32x4*)(wp + (size_t)(k + i) * NMOD));
#pragma unroll
    for (int i = 0; i < 16; ++i)
#pragma unroll
      for (int r = 0; r < 5; ++r) acc[r] += S[r * ROWS + k + i] * w[i]; }
  f32x4 bias = {0.f, 0.f, 0.f, 0.f}; if (kc == 0) bias = *(const f32x4*)(bm + col);
#pragma unroll
  for (int r = 0; r < 5; ++r)
#pragma unroll
    for (int e = 0; e < 4; ++e) __hip_atomic_fetch_add(MODl + (size_t)r * NMOD + col + e, acc[r][e] + bias[e], __ATOMIC_RELAXED, __HIP_MEMORY_SCOPE_AGENT);
  __syncthreads();
}
__device__ __forceinline__ void fold_item(const float* __restrict__ wout, const float* __restrict__ pscale, const float* __restrict__ poolw, bf16_t* __restrict__ W1OUT, int it, unsigned char* lds) {
  int tid = threadIdx.x; asm volatile("" : "+v"(tid));
  const int lane = tid & 63, wave = __builtin_amdgcn_readfirstlane(tid >> 6), g = it >> 5, n0 = (it & 31) * 64;
  float* Ws = (float*)lds;
  for (int i = tid; i < 8192; i += NTHR) { const int d = i >> 6, nn = i & 63; Ws[i] = wout[(size_t)(1536 + g * 128 + d) * DM + n0 + nn] * pscale[g * 128 + d]; }
  __syncthreads();
  float acc[16];
#pragma unroll
  for (int i = 0; i < 16; ++i) acc[i] = 0.f;
  float* PW = (float*)(lds + 32768) + wave * 2048;
  { const float* pw = poolw + (size_t)(g * 128 + wave * 16) * 128;
#pragma unroll 8
    for (int j = 0; j < 32; ++j) PW[lane + 64 * j] = pw[lane + 64 * j]; }
  asm volatile("s_waitcnt vmcnt(0) lgkmcnt(0)" ::: "memory");
  for (int d = 0; d < 128; d += 4) { const float w0 = Ws[d * 64 + lane], w1 = Ws[(d + 1) * 64 + lane], w2 = Ws[(d + 2) * 64 + lane], w3 = Ws[(d + 3) * 64 + lane];
#pragma unroll
    for (int i = 0; i < 16; ++i) { const f32x4 p = *(const f32x4*)(PW + i * 128 + d); acc[i] += (p.x * w0 + p.y * w1) + (p.z * w2 + p.w * w3); } }
  bf16_t* dst = W1OUT + (size_t)(n0 + lane) * DM + 1536 + g * 128 + wave * 16;
  u32x4 w0, w1; w0.x = pk2(acc[0], acc[1]); w0.y = pk2(acc[2], acc[3]); w0.z = pk2(acc[4], acc[5]); w0.w = pk2(acc[6], acc[7]);
  w1.x = pk2(acc[8], acc[9]); w1.y = pk2(acc[10], acc[11]); w1.z = pk2(acc[12], acc[13]); w1.w = pk2(acc[14], acc[15]);
  *(u32x4*)dst = w0; *(u32x4*)(dst + 8) = w1;
  __syncthreads();
}

__device__ __forceinline__ void attn_decode(int i, int c, int& b, int& h, int& qb) {
  const int x = c & 7, j = i * 32 + (c >> 3), pair = 2 * x + j / 48, idx = j % 48;
  b = pair >> 2; h = (pair & 3) * 3 + idx / 16; qb = idx & 15;
}

template <class T> __device__ __forceinline__ T* gptr(T* p) { __attribute__((address_space(1))) T* g = (__attribute__((address_space(1))) T*)p; asm volatile("" : "+s"(g)); return (T*)g; }
__device__ __forceinline__ unsigned char* lw(unsigned char* p) { return gptr(p); }
#define MOD   ((float*)(lw(ws) + WS_MOD))
#define W0IN  ((bf16_t*)(lw(ws) + WS_W0IN))
#define W0OUT ((bf16_t*)(lw(ws) + WS_W0OUT))
#define W0GU  ((bf16_t*)(lw(ws) + WS_W0GU))
#define W0DN  ((bf16_t*)(lw(ws) + WS_W0DN))
#define W1IN  ((bf16_t*)(lw(ws) + WS_W1IN))
#define W1OUT ((bf16_t*)(lw(ws) + WS_W1OUT))
#define W1GU  ((bf16_t*)(lw(ws) + WS_W1GU))
#define W1DN  ((bf16_t*)(lw(ws) + WS_W1DN))
#define XN    ((bf16_t*)(lw(ws) + WS_XN))
#define H     ((bf16_t*)(lw(ws) + WS_H))
#define PROJ  ((bf16_t*)(lw(ws) + WS_PROJ))
#define CAT   ((bf16_t*)(lw(ws) + WS_CAT))
#define HID   ((bf16_t*)(lw(ws) + WS_HID))
#define PP    ((float*)(lw(ws) + WS_PP))
#define KCB   ((bf16_t*)(lw(ws) + WS_KC))
#define VCB   ((bf16_t*)(lw(ws) + WS_VC))
#define SSXI(k) ((float*)(lw(ws) + WS_SSX) + (size_t)(k) * 68 * 256 * 8)
#define CNTI(k) ((unsigned*)(lw(ws) + WS_CNT) + (k) * 68 * 64)
#ifndef ONLY_PHASE
#define ONLY_PHASE -1
#endif
#define PH(k) (ONLY_PHASE < 0 || ONLY_PHASE == (k))
#define A (*Ap)
#define GRID_BAR() xcd_barrier(bar)
template <int layer, bool FIXED>
__device__ __forceinline__ void attn_units(const __attribute__((address_space(4))) Args* Ap, unsigned char* ws, unsigned char* lds, const int c, const int nunits, const float sbound) {
      for (int i = 0; ; ++i) {
        const int L = i * 256 + c; if (L >= nunits || i >= 4) break;
        att::UnitArgs u;
        if (L < 768) { int b, h, qb; attn_decode(i, c, b, h, qb);
          u.qrow0 = b * SEQ + qb * 256; u.qcol = h * 128; u.kvbase = (b * 4 + h / 3) * 4352 * 128;
          u.tpos0 = qb * 256; u.rope = 1; u.ocol = h * 128; u.nB = -sbound;
          if (layer == 0) { u.kstart = 0; u.NT = 68; u.sinkl2 = 0.f; u.has_sink = 0; }
          else { u.kstart = qb * 256 - 128; u.NT = 12; u.sinkl2 = gptr(A.l1_sink)[h] * 1.4426950408889634f; u.has_sink = 1; }
        } else { const int j = L - 768, b = j / 12, h = j % 12;
          u.qrow0 = MLAT + b * CTXL; u.qcol = h * 128; u.kvbase = (b * 4 + h / 3) * 4352 * 128;
          u.tpos0 = 0; u.rope = 0; u.ocol = h * 128; u.kstart = 0; u.NT = 4; u.sinkl2 = 0.f; u.has_sink = 0; u.nB = -sbound; }
        if constexpr (layer == 0) att::attn_unit<LDP0, false, FIXED>(PROJ, KCB, VCB, CAT, gptr(A.l0_q_g), u, (char*)lds);
        else att::attn_unit<LDP1, true, FIXED>(PROJ, KCB, VCB, CAT, gptr(A.l1_q_g), u, (char*)lds);
        __syncthreads();
      }
}
template <int layer>
__device__ __forceinline__ void layer_fwd(const __attribute__((address_space(4))) Args* Ap, unsigned char* ws, unsigned char* lds, const XcdBarrier bar, const int G, const int c) {
  int tid_ = threadIdx.x; asm volatile("" : "+v"(tid_));
  const int tid = tid_, lane = tid & 63, wave = __builtin_amdgcn_readfirstlane(tid >> 6), gw = c * NWAVES + wave, ngw = G * NWAVES; (void)tid;
  PG8_LAS unsigned char* ldsl = (PG8_LAS unsigned char*)lds;
    const float* mod = MOD + (size_t)layer * 5 * NMOD;
    const int Mrows = layer == 0 ? MALL : MLAT;
    if constexpr (layer == 0) {
      if (PH(3)) norm_mod_rows<false, false>(gptr(A.x), gptr(A.ctx), MALL, gptr(A.l0_norm1_g), mod, 0, 2048, XN, gw, ngw, lane);
      GRID_BAR();
    }
    if (PH(4)) {
      if constexpr (layer == 1) {
        norm_mod_rows<true, true>(H, H + (size_t)MLAT * DM, MALL, gptr(A.l1_norm1_g), mod, 0, 2048, XN, gw, ngw, lane, PP, MOD + 4 * NMOD + 5 * 2048, MLAT);
        if (gw < MCTX) { __builtin_amdgcn_fence(__ATOMIC_RELEASE, "agent"); asm volatile("s_waitcnt vmcnt(0)" ::: "memory");
          if (lane == 0) __hip_atomic_fetch_add((unsigned*)(lw(ws) + WS_CNTX), 1u, __ATOMIC_RELAXED, __HIP_MEMORY_SCOPE_AGENT); }
      }
      pg8::Gemm g{XN, layer == 0 ? W0IN : W1IN, layer == 0 ? MALL : MLAT, layer == 0 ? LDP0 : LDP1, DM, DM}; pg8::StaticOrder S; S.init(g.M, g.N, G, c);
      pg8::EpiStoreBf16 E{PROJ, g.N, VCB};
      pg8::gemm_phase<pg8::EpiStoreBf16, pg8::StaticOrder, true, true>(ldsl, g, S, E);
      if (layer == 1) {
        if (c < 128) {
          if (threadIdx.x == 0) { unsigned sp = 0; unsigned* cx = (unsigned*)(lw(ws) + WS_CNTX);
            while (__hip_atomic_load(cx, __ATOMIC_RELAXED, __HIP_MEMORY_SCOPE_AGENT) < (unsigned)MCTX) { __builtin_amdgcn_s_sleep(2); if (++sp > (1u << 22)) break; }
            __builtin_amdgcn_fence(__ATOMIC_ACQUIRE, "agent"); asm volatile("s_waitcnt vmcnt(0)" ::: "memory"); }
          __syncthreads();
          pg8::Gemm g2{XN, W1IN, MALL, LDP1, 256, DM}; pg8::CtxSplitOrder S2{8, 4, 6, 128, G, c}; pg8::EpiPartF32 E2{PP, 1024, 1536};
          pg8::gemm_phase<pg8::EpiPartF32, pg8::CtxSplitOrder, true, true>(ldsl, g2, S2, E2); } }
      if (layer == 0 && c >= 64) {
        constexpr int I_IN1 = 32 * 48, I_OUT1 = 24 * 32, I_GU = 32 * 88, I_DN = 88 * 32; int ln = lane; asm volatile("" : "+v"(ln));
        for (int it = (c - 64) * NWAVES + wave; it < I_IN1 + I_OUT1 + 2 * I_GU; it += 192 * NWAVES) { int r = it;
          if (r < I_IN1) { tr_item<0>(gptr(A.l1_w_in), 3072, W1IN, DM, r, ln, lds + wave * 9216); continue; } r -= I_IN1;
          if (r < I_OUT1) { tr_item<0>(gptr(A.l1_w_out), DM, W1OUT, DM, r, ln, lds + wave * 9216); continue; } r -= I_OUT1;
          if (r < I_GU) { tr_item<1>(gptr(A.l1_w_gate), FFN, W1GU, DM, r, ln, lds + wave * 9216); continue; } r -= I_GU;
          tr_item<2>(gptr(A.l1_w_up), FFN, W1GU, DM, r, ln, lds + wave * 9216); } }
    }
    GRID_BAR();
    if (PH(5)) { int ln = lane; asm volatile("" : "+v"(ln)); if (layer == 0) { for (int row = gw; row < MALL; row += ngw) { knorm_row<LDP0>(PROJ, KCB, VCB, row, gptr(A.l0_k_g), ln); conv_row(PROJ, CAT, row, gptr(A.l0_conv_w), ln); } }
    else            { for (int row = gw; row < MALL; row += ngw) { if (row < MLAT) { knorm_row<LDP1>(PROJ, KCB, VCB, row, gptr(A.l1_k_g), ln); pool_row(PROJ, CAT, row, ln); } else kv_ctx_from_part(PP, KCB, VCB, row, gptr(A.l1_k_g), ln); } } }
    GRID_BAR();
    if (PH(6)) {
      const int nunits = layer == 0 ? 816 : 768;
      float sbound; { const float* qgp = layer == 0 ? gptr(A.l0_q_g) : gptr(A.l1_q_g); const float* kgp = layer == 0 ? gptr(A.l0_k_g) : gptr(A.l1_k_g);
        float mq = fmaxf(fabsf(qgp[lane]), fabsf(qgp[lane + 64])), mk = fmaxf(fabsf(kgp[lane]), fabsf(kgp[lane + 64]));
#pragma unroll
        for (int o = 1; o < 64; o <<= 1) { mq = fmaxf(mq, __shfl_xor(mq, o)); mk = fmaxf(mk, __shfl_xor(mk, o)); }
        sbound = 128.0f * mq * mk * att::SCALE * 1.4426950408889634f * 1.02f; }
      const bool fixed_sm = __builtin_amdgcn_readfirstlane(sbound <= 60.0f ? 1 : 0) != 0;
      if (fixed_sm) attn_units<layer, true>(Ap, ws, lds, c, nunits, sbound); else attn_units<layer, false>(Ap, ws, lds, c, nunits, sbound);
      if (layer == 0 && c >= 48) {
        const int idx = c - 48;
        if (idx < 128) mod_item(gptr(A.l0_w_mod), gptr(A.l0_b_mod), gptr(A.c), gptr(A.c_ctx), MOD, 64 + idx, lds);
        else { int ln = lane; asm volatile("" : "+v"(ln));
          for (int it = (idx - 128) * NWAVES + wave; it < 32 * 32; it += 80 * NWAVES) tr_item<0>(gptr(A.l0_w_out), DM, W0OUT, DM, it, ln, lds + wave * 9216); } }
    }
    GRID_BAR();
    if (PH(7)) {
      pg8::Gemm g{CAT, layer == 0 ? W0OUT : W1OUT, Mrows, DM, DM, DM}; pg8::PanelOrder S{Mrows / 256, G, c};
      if constexpr (layer == 0) { pg8::EpiResNorm<false, 0> E{gptr(A.x), gptr(A.ctx) - (size_t)MLAT * DM, mod + 2 * 2048, H, XN, nullptr, gptr(A.l0_norm2_g), mod + 4 * 2048, mod + 3 * 2048, SSXI(0), CNTI(0), ldsl + 131072 + 2048};
        pg8::gemm_phase<pg8::EpiResNorm<false, 0>, pg8::PanelOrder, true, true>(ldsl, g, S, E); }
      else { pg8::EpiResNorm<true, 0> E{H, H, mod + 2 * 2048, H, XN, nullptr, gptr(A.l1_norm2_g), mod + 4 * 2048, mod + 3 * 2048, SSXI(2), CNTI(2), ldsl + 131072 + 2048};
        pg8::gemm_phase<pg8::EpiResNorm<true, 0>, pg8::PanelOrder, true, true>(ldsl, g, S, E); }
      if (layer == 0 && !(c < 64 && (c & 7) < 4)) {
        const int idx = c >= 64 ? 32 + (c - 64) : (c >> 3) * 4 + ((c & 7) - 4);
        constexpr int I_GU = 32 * 88, I_DN = 88 * 32; int ln = lane; asm volatile("" : "+v"(ln));
        for (int it = idx * NWAVES + wave; it < 2 * I_GU + I_DN; it += 224 * NWAVES) { int r = it;
          if (r < I_GU) { tr_item<1>(gptr(A.l0_w_gate), FFN, W0GU, DM, r, ln, lds + wave * 9216); continue; } r -= I_GU;
          if (r < I_GU) { tr_item<2>(gptr(A.l0_w_up), FFN, W0GU, DM, r, ln, lds + wave * 9216); continue; } r -= I_GU;
          tr_item<0>(gptr(A.l0_w_down), DM, W0DN, FFN, r, ln, lds + wave * 9216); } }
    }
    GRID_BAR();
    if (PH(9)) {
      pg8::Gemm g{XN, layer == 0 ? W0GU : W1GU, Mrows, 2 * FFN, DM, DM}; pg8::StaticOrder S; S.init(g.M, g.N, G, c);
      pg8::EpiSwiGLU E{HID, FFN};
      pg8::gemm_phase<pg8::EpiSwiGLU, pg8::StaticOrder, true, true>(ldsl, g, S, E);
      if (layer == 0 && c >= 176) {
        for (int it = c - 176; it < 192; it += 80) mod_item(gptr(A.l1_w_mod), gptr(A.l1_b_mod), gptr(A.c), gptr(A.c_ctx), MOD + (size_t)5 * NMOD, it, lds); }
    }
    GRID_BAR();
    if (PH(10)) {
      pg8::Gemm g{HID, layer == 0 ? W0DN : W1DN, MLAT, DM, FFN, FFN}; pg8::PanelOrder S{MLAT / 256, G, c};
      if constexpr (layer == 0) { const float* mod1 = MOD + (size_t)5 * NMOD;
        pg8::EpiResNorm<true, 0> E{H, H, mod + 5 * 2048, H, XN, nullptr, gptr(A.l1_norm1_g), mod1 + 2048, mod1, SSXI(1), CNTI(1), ldsl + 131072 + 2048};
        pg8::gemm_phase<pg8::EpiResNorm<true, 0>, pg8::PanelOrder, true, true>(ldsl, g, S, E); }
      else { pg8::EpiResNorm<true, 1> E{H, H, mod + 5 * 2048, nullptr, nullptr, gptr(A.out), gptr(A.final_g), nullptr, nullptr, SSXI(3), CNTI(3), ldsl + 131072 + 2048};
        pg8::gemm_phase<pg8::EpiResNorm<true, 1>, pg8::PanelOrder, true, true>(ldsl, g, S, E); }
      if (layer == 0) {
        if (c < 128) { pg8::Gemm g2{HID, W0DN, MALL, DM, 1408, FFN}; pg8::CtxSplitOrder S2{4, 8, 0, 128, G, c}; pg8::EpiPartF32 E2{PP, 2048, 0};
          pg8::gemm_phase<pg8::EpiPartF32, pg8::CtxSplitOrder, true, true>(ldsl, g2, S2, E2);
 }
        else { const int idx = c - 128; fold_item(gptr(A.l1_w_out), gptr(A.l1_pool_scale), gptr(A.l1_pool_w), W1OUT, idx, lds); int ln = lane; asm volatile("" : "+v"(ln));
          for (int it = idx * NWAVES + wave; it < 88 * 32; it += 128 * NWAVES) tr_item<0>(gptr(A.l1_w_down), DM, W1DN, FFN, it, ln, lds + wave * 9216); }
      }
    }
    if (layer == 0) GRID_BAR();
}
__global__ void __launch_bounds__(NTHR, 2) fwd_mega(Args Araw) {
  const __attribute__((address_space(4))) Args* Ap = (const __attribute__((address_space(4))) Args*)__builtin_amdgcn_kernarg_segment_ptr();
  asm volatile("" : "+s"(Ap));
  extern __shared__ __attribute__((aligned(16))) unsigned char lds[];
  cg::grid_group grid = cg::this_grid();
  const int tid = threadIdx.x, lane = tid & 63, wave = __builtin_amdgcn_readfirstlane(tid >> 6);
  const int G = gridDim.x, c = blockIdx.x, gw = c * NWAVES + wave, ngw = G * NWAVES;
  unsigned char* ws = gptr(A.ws);
  PG8_LAS unsigned char* ldsl = (PG8_LAS unsigned char*)lds;
  volatile LAS unsigned* bst = (volatile LAS unsigned*)((LAS unsigned char*)lds + 131072 + 1024);
  if (tid < 64) ((LAS unsigned*)((LAS unsigned char*)lds + 131072 + 1024))[tid] = 0u;
  __syncthreads();
  XcdBarrier bar = xcd_barrier_post((unsigned*)(ws + WS_BAR), bst);

  if (PH(0)) {
    if (c < 128) mod_item<32>(gptr(A.l0_w_mod), gptr(A.l0_b_mod), gptr(A.c), gptr(A.c_ctx), MOD, c, lds);
    else { int ln = lane; asm volatile("" : "+v"(ln));
      for (int it = (c - 128) * NWAVES + wave; it < 32 * 64; it += 128 * NWAVES) tr_item<0>(gptr(A.l0_w_in), 4096, W0IN, DM, it, ln, lds + wave * 9216); }
  }
  GRID_BAR();
  if (gridDim.x == 0x7fffffu) grid.sync();

  layer_fwd<0>(Ap, ws, lds, bar, G, c);
  layer_fwd<1>(Ap, ws, lds, bar, G, c);
#undef A
}
#undef MOD
#undef W0IN
#undef W0OUT
#undef W0GU
#undef W0DN
#undef W1IN
#undef W1OUT
#undef W1GU
#undef W1DN
#undef XN
#undef H
#undef PROJ
#undef CAT
#undef HID
#undef PP
#undef KCB
#undef VCB
#undef SSXI
#undef CNTI


extern "C" void kernel_launch(void* const* d_in, const int* in_sizes, int n_in, void* d_out, int out_size, void* d_ws, size_t ws_size, hipStream_t stream) {
  static int grid_blocks = 0;
  if (grid_blocks == 0) {
    if (n_in != 31 || in_sizes[0] != MLAT * DM || out_size != MLAT * DM || ws_size < WS_END) {
      fprintf(stderr, "kernel_launch: unexpected problem: n_in %d in0 %d out %d ws %zu (need %zu)\n", n_in, n_in > 0 ? in_sizes[0] : -1, out_size, ws_size, (size_t)WS_END); grid_blocks = -1; return; }
    int dev = 0, cus = 0, per_cu = 0;
    hipGetDevice(&dev); hipDeviceGetAttribute(&cus, hipDeviceAttributeMultiprocessorCount, dev);
    if (hipFuncSetAttribute((const void*)fwd_mega, hipFuncAttributeMaxDynamicSharedMemorySize, LDS_BYTES) != hipSuccess) { fprintf(stderr, "kernel_launch: hipFuncSetAttribute failed\n"); grid_blocks = -1; return; }
    hipOccupancyMaxActiveBlocksPerMultiprocessor(&per_cu, (const void*)fwd_mega, NTHR, LDS_BYTES);
    (void)hipGetLastError();
    if (per_cu < 1) per_cu = 1;
    grid_blocks = cus;
    if (grid_blocks != 256) fprintf(stderr, "kernel_launch: note: %d CUs (kernel assumes a 256-workgroup grid for its static work split)\n", grid_blocks);
    grid_blocks = 256;
  }
  if (grid_blocks < 0) return;
  if (hipMemsetAsync((char*)d_ws, 0, ZERO_BYTES, stream) != hipSuccess) { fprintf(stderr, "kernel_launch: memset failed\n"); return; }
  Args a{};
  const float** p = (const float**)&a;
  for (int i = 0; i < 31; ++i) p[i] = (const float*)d_in[i];
  a.out = (float*)d_out; a.ws = (unsigned char*)d_ws;
  void* args[] = {&a};
  hipError_t e = hipLaunchCooperativeKernel((const void*)fwd_mega, dim3(grid_blocks), dim3(NTHR), args, LDS_BYTES, stream);
  if (e != hipSuccess) fprintf(stderr, "kernel_launch: cooperative launch failed: %s\n", hipGetErrorString(e));
}
```

```cpp
#include <hip/hip_runtime.h>
#include <hip/hip_cooperative_groups.h>
#include <cstdio>
#include <cstdint>
#include <cstddef>
namespace pg8 {
#define PG8_LAS __attribute__((address_space(3)))
typedef unsigned short bf16_t;
typedef short bf16x8 __attribute__((ext_vector_type(8)));
typedef float f32x4 __attribute__((ext_vector_type(4)));
typedef unsigned u32x4 __attribute__((ext_vector_type(4)));
constexpr int BM = 256, BK = 64, HALF = 128, HTB = HALF * BK * 2  , STAGE_BYTES = 8 * HTB, NXCD = 8, WGM = 8;

__host__ __device__ __forceinline__ int lds_byte(int r, int c) { const int st = (r >> 4) * 2 + (c >> 5), rr = r & 15, cc = c & 31, ob = rr * 64 + cc * 2; return st * 1024 + (ob ^ (((ob >> 9) & 1) << 5)); }
__host__ __device__ __forceinline__ void stage_rc(int b, int& R, int& C) { const int st = b / 1024, sb = b % 1024, swz = sb ^ (((sb >> 9) & 1) << 5); R = (st >> 1) * 16 + swz / 64; C = (st & 1) * 32 + (swz % 64) / 2; }
__host__ __device__ __forceinline__ int perm32(int rho) { const int n = rho >> 4, i = rho & 15; return 8 * (i >> 2) + 4 * n + (i & 3); }

struct Unit { int pm, pn, ks; };
struct Gemm { const bf16_t* A; const bf16_t* Bt; int M, N, K, ld; };

struct StaticOrder {
    int nM, nN, nwg, G, c;
    __host__ __device__ void init(int M, int N, int G_, int c_) { nM = M / BM; nN = N / BM; nwg = nM * nN; G = G_; c = c_; }
    __host__ __device__ bool next(int i, Unit& u) const {
        const long L = (long)i * G + c; if (L >= nwg) return false;
        int wgid = (int)L; { const int q = nwg / NXCD, r = nwg % NXCD, xcd = wgid % NXCD, off = wgid / NXCD; wgid = (xcd < r ? xcd * (q + 1) : r * (q + 1) + (xcd - r) * q) + off; }
        const int nig = WGM * nN, gid = wgid / nig, fm = gid * WGM, gsz = (nM - fm) < WGM ? (nM - fm) : WGM;
        u.pm = fm + ((wgid % nig) % gsz); u.pn = (wgid % nig) / gsz; u.ks = 0; return true;
    }
    __device__ __forceinline__ void a_ready(const Unit&) const {}
    __device__ __forceinline__ void done(const Unit&) const {}
};

__device__ __forceinline__ unsigned cvt_pk_bf16(float lo, float hi) { unsigned r; asm volatile("v_cvt_pk_bf16_f32 %0, %1, %2" : "=v"(r) : "v"(lo), "v"(hi)); return r; }
typedef float f32x2 __attribute__((ext_vector_type(2)));
struct EpiStoreBf16 {
    static constexpr bool PERM = true, AFTER_DRAIN = false;
    bf16_t* O; int ldc; bf16_t* VC;
    __device__ __forceinline__ void operator()(const f32x4 (&acc)[2][2][4][2], const Unit& u, int wr, int wc, int fr, int fq) const {
        const int row0 = u.pm * BM + wr * 64 + fr; const int col0 = u.pn * BM + wc * 32 + 8 * fq;
        const bool isv = (u.pn == 8 || u.pn == 9);
#pragma unroll
        for (int ai = 0; ai < 2; ++ai)
#pragma unroll
            for (int m = 0; m < 4; ++m) { const int row = row0 + ai * HALF + m * 16; bf16_t* rowp = O + (size_t)row * ldc + col0;
                if (isv) { const int b = row < 16384 ? (row >> 12) : ((row - 16384) >> 8), pos = row < 16384 ? 256 + (row & 4095) : ((row - 16384) & 255);
                    rowp = VC + ((size_t)(b * 4 + 2 * (u.pn - 8)) * 4352 + pos) * 128 + wc * 32 + 8 * fq; }
#pragma unroll
                for (int bj = 0; bj < 2; ++bj) { const f32x4 v0 = acc[ai][bj][m][0], v1 = acc[ai][bj][m][1];
                    u32x4 w; w.x = cvt_pk_bf16(v0[0], v0[1]); w.y = cvt_pk_bf16(v0[2], v0[3]); w.z = cvt_pk_bf16(v1[0], v1[1]); w.w = cvt_pk_bf16(v1[2], v1[3]);
                    *(u32x4*)(rowp + (isv ? (size_t)bj * 4352 * 128 : (size_t)bj * HALF)) = w; } }
    }
};
__device__ __forceinline__ float silu_f(float x) { return x * __builtin_amdgcn_rcpf(1.0f + __builtin_amdgcn_exp2f(-1.4426950408889634f * x)); }
struct EpiSwiGLU {
    static constexpr bool PERM = true, AFTER_DRAIN = false;
    bf16_t* O; int ldc;
    __device__ __forceinline__ void operator()(const f32x4 (&acc)[2][2][4][2], const Unit& u, int wr, int wc, int fr, int fq) const {
        const int row0 = u.pm * BM + wr * 64 + fr; const int col0 = u.pn * HALF + wc * 32 + 8 * fq;
#pragma unroll
        for (int ai = 0; ai < 2; ++ai)
#pragma unroll
            for (int m = 0; m < 4; ++m) { bf16_t* rowp = O + (size_t)(row0 + ai * HALF + m * 16) * ldc + col0;
                const f32x4 g0 = acc[ai][0][m][0], g1 = acc[ai][0][m][1], u0 = acc[ai][1][m][0], u1 = acc[ai][1][m][1];
                u32x4 w; w.x = cvt_pk_bf16(silu_f(g0[0]) * u0[0], silu_f(g0[1]) * u0[1]); w.y = cvt_pk_bf16(silu_f(g0[2]) * u0[2], silu_f(g0[3]) * u0[3]);
                w.z = cvt_pk_bf16(silu_f(g1[0]) * u1[0], silu_f(g1[1]) * u1[1]); w.w = cvt_pk_bf16(silu_f(g1[2]) * u1[2], silu_f(g1[3]) * u1[3]);
                *(u32x4*)rowp = w; }
    }
};
template <bool BASE_BF16, bool OUT_BF16>
struct EpiResGate {
    static constexpr bool PERM = true, AFTER_DRAIN = false;
    const void* base_lat; const void* base_ctx; void* out; const float* gate;
    __device__ __forceinline__ void operator()(const f32x4 (&acc)[2][2][4][2], const Unit& u, int wr, int wc, int fr, int fq) const {
        const int col0 = u.pn * BM + wc * 32 + 8 * fq; const int modrow = u.pm < 64 ? (u.pm >> 4) : 4;
        const void* base = u.pm < 64 ? base_lat : base_ctx;
        f32x4 gv[2][2];
#pragma unroll
        for (int bj = 0; bj < 2; ++bj)
#pragma unroll
            for (int n = 0; n < 2; ++n) gv[bj][n] = *(const f32x4*)(gate + modrow * 12288 + col0 + bj * HALF + 4 * n);
#pragma unroll
        for (int ai = 0; ai < 2; ++ai)
#pragma unroll
            for (int m = 0; m < 4; ++m) { const size_t off = (size_t)(u.pm * BM + ai * HALF + wr * 64 + m * 16 + fr) * 2048 + col0;
#pragma unroll
                for (int bj = 0; bj < 2; ++bj) { f32x4 b0, b1;
                    if constexpr (BASE_BF16) { const u32x4 w = *(const u32x4*)((const bf16_t*)base + off + bj * HALF);
                        b0 = (f32x4){__uint_as_float(w.x << 16), __uint_as_float(w.x & 0xffff0000u), __uint_as_float(w.y << 16), __uint_as_float(w.y & 0xffff0000u)};
                        b1 = (f32x4){__uint_as_float(w.z << 16), __uint_as_float(w.z & 0xffff0000u), __uint_as_float(w.w << 16), __uint_as_float(w.w & 0xffff0000u)}; }
                    else { b0 = *(const f32x4*)((const float*)base + off + bj * HALF); b1 = *(const f32x4*)((const float*)base + off + bj * HALF + 4); }
                    const f32x4 o0 = b0 + gv[bj][0] * acc[ai][bj][m][0], o1 = b1 + gv[bj][1] * acc[ai][bj][m][1];
                    if constexpr (OUT_BF16) { u32x4 w; w.x = cvt_pk_bf16(o0[0], o0[1]); w.y = cvt_pk_bf16(o0[2], o0[3]); w.z = cvt_pk_bf16(o1[0], o1[1]); w.w = cvt_pk_bf16(o1[2], o1[3]);
                        *(u32x4*)((bf16_t*)out + off + bj * HALF) = w; }
                    else { *(f32x4*)((float*)out + off + bj * HALF) = o0; *(f32x4*)((float*)out + off + bj * HALF + 4) = o1; } } }
    }
};
struct EpiPartF32 {
    static constexpr bool PERM = false, AFTER_DRAIN = false;
    float* out; int ldp, col0;
    __device__ __forceinline__ void operator()(const f32x4 (&acc)[2][2][4][2], const Unit& u, int wr, int wc, int fr, int fq) const {
        const int colb = u.pn * BM + wc * 32 + 4 * fq - col0;
#pragma unroll
        for (int ai = 0; ai < 2; ++ai)
#pragma unroll
            for (int m = 0; m < 4; ++m) { const size_t off = ((size_t)u.ks * 1024 + (size_t)((u.pm - 64) * BM + ai * HALF + wr * 64 + m * 16 + fr)) * ldp + colb;
#pragma unroll
                for (int bj = 0; bj < 2; ++bj)
#pragma unroll
                    for (int n = 0; n < 2; ++n) *(f32x4*)(out + off + bj * HALF + n * 16) = acc[ai][bj][m][n]; }
    }
};
struct CtxSplitOrder {
    int nks, npn, pn0, nsub, G, c;
    __device__ bool next(int i, Unit& u) const { const int L = i * G + c; if (L >= nsub) return false; u.ks = L % nks; const int t = L / nks; u.pn = pn0 + t % npn; u.pm = 64 + t / npn; return true; }
    __device__ __forceinline__ void a_ready(const Unit&) const {}
    __device__ __forceinline__ void done(const Unit&) const {}
};

template <bool BASE_BF16, int MODE>
struct EpiResNorm {
    static constexpr bool PERM = true, AFTER_DRAIN = false;
    const void* base_lat; const void* base_ctx; const float* gate;
    bf16_t* Hout; bf16_t* XNout; float* Fout;
    const float* g; const float* sc; const float* sh;
    float* ssx; unsigned* cnt;
    PG8_LAS unsigned char* xl;
    __device__ __forceinline__ void operator()(f32x4 (&acc)[2][2][4][2], const Unit& u, int wr, int wc, int fr, int fq) const {
        const int tid = threadIdx.x, lane = tid & 63;
        const int col0 = u.pn * BM + wc * 32 + 8 * fq; const int modrow = u.pm < 64 ? (u.pm >> 4) : 4;
        const void* base = u.pm < 64 ? base_lat : base_ctx;
        PG8_LAS float* P = (PG8_LAS float*)xl; PG8_LAS float* S = (PG8_LAS float*)(xl + 4096);
#pragma unroll
        for (int bj = 0; bj < 2; ++bj) { const f32x4 g0 = *(const f32x4*)(gate + modrow * 12288 + col0 + bj * HALF), g1 = *(const f32x4*)(gate + modrow * 12288 + col0 + bj * HALF + 4);
#pragma unroll
            for (int ai = 0; ai < 2; ++ai)
#pragma unroll
                for (int m = 0; m < 4; ++m) { const size_t off = (size_t)(u.pm * BM + ai * HALF + wr * 64 + m * 16 + fr) * 2048 + col0 + bj * HALF; f32x4 b0, b1;
                    if constexpr (BASE_BF16) { const u32x4 w = *(const u32x4*)((const bf16_t*)base + off);
                        b0 = (f32x4){__uint_as_float(w.x << 16), __uint_as_float(w.x & 0xffff0000u), __uint_as_float(w.y << 16), __uint_as_float(w.y & 0xffff0000u)};
                        b1 = (f32x4){__uint_as_float(w.z << 16), __uint_as_float(w.z & 0xffff0000u), __uint_as_float(w.w << 16), __uint_as_float(w.w & 0xffff0000u)}; }
                    else { b0 = *(const f32x4*)((const float*)base + off); b1 = *(const f32x4*)((const float*)base + off + 4); }
                    acc[ai][bj][m][0] = b0 + g0 * acc[ai][bj][m][0]; acc[ai][bj][m][1] = b1 + g1 * acc[ai][bj][m][1];
                    asm volatile("" : "+v"(acc[ai][bj][m][0]), "+v"(acc[ai][bj][m][1]));
                    if (m & 1) asm volatile("" ::: "memory"); } }
#pragma unroll
        for (int ai = 0; ai < 2; ++ai)
#pragma unroll
            for (int m = 0; m < 4; ++m) { float s = 0.f;
#pragma unroll
                for (int bj = 0; bj < 2; ++bj)
#pragma unroll
                    for (int n = 0; n < 2; ++n) { const f32x4 x = acc[ai][bj][m][n]; s += (x[0] * x[0] + x[1] * x[1]) + (x[2] * x[2] + x[3] * x[3]); }
                s += __shfl_xor(s, 16); s += __shfl_xor(s, 32);
                if (fq == 0) P[(ai * HALF + wr * 64 + m * 16 + fr) * 4 + wc] = s; }
        asm volatile("s_waitcnt lgkmcnt(0)" ::: "memory"); __builtin_amdgcn_s_barrier(); asm volatile("" ::: "memory");
        if (tid < 256) { const float tot = (P[tid * 4 + 0] + P[tid * 4 + 1]) + (P[tid * 4 + 2] + P[tid * 4 + 3]);
            __hip_atomic_store(ssx + ((size_t)u.pm * 256 + tid) * 8 + u.pn, tot, __ATOMIC_RELAXED, __HIP_MEMORY_SCOPE_AGENT); }
        asm volatile("s_waitcnt vmcnt(0)" ::: "memory");
        if (tid < 256 && lane == 0) __hip_atomic_fetch_add(cnt + 64 * u.pm, 1u, __ATOMIC_RELAXED, __HIP_MEMORY_SCOPE_AGENT);
        if constexpr (MODE == 0) {
#pragma unroll
            for (int bj = 0; bj < 2; ++bj)
#pragma unroll
                for (int ai = 0; ai < 2; ++ai)
#pragma unroll
                    for (int m = 0; m < 4; ++m) { const size_t off = (size_t)(u.pm * BM + ai * HALF + wr * 64 + m * 16 + fr) * 2048 + col0 + bj * HALF; const f32x4 h0 = acc[ai][bj][m][0], h1 = acc[ai][bj][m][1];
                        u32x4 w; w.x = cvt_pk_bf16(h0[0], h0[1]); w.y = cvt_pk_bf16(h0[2], h0[3]); w.z = cvt_pk_bf16(h1[0], h1[1]); w.w = cvt_pk_bf16(h1[2], h1[3]);
                        *(u32x4*)(Hout + off) = w; } }
        if (tid < 64) { unsigned sp = 0;
            while ((unsigned)__builtin_amdgcn_readfirstlane(__hip_atomic_load(cnt + 64 * u.pm, __ATOMIC_RELAXED, __HIP_MEMORY_SCOPE_AGENT)) < 32u) { __builtin_amdgcn_s_sleep(2); if (++sp > (1u << 22)) break; }
            __builtin_amdgcn_fence(__ATOMIC_ACQUIRE, "agent"); }
        asm volatile("s_waitcnt vmcnt(0) lgkmcnt(0)" ::: "memory"); __builtin_amdgcn_s_barrier(); asm volatile("" ::: "memory");
        if (tid < 256) { const float* slot = ssx + ((size_t)u.pm * 256 + tid) * 8; float q = 0.f;
#pragma unroll
            for (int t = 0; t < 8; ++t) q += __hip_atomic_load(slot + t, __ATOMIC_RELAXED, __HIP_MEMORY_SCOPE_AGENT);
            S[tid] = 1.0f / sqrtf(q * (1.0f / 2048.0f) + 1e-6f); }
        asm volatile("s_waitcnt vmcnt(0) lgkmcnt(0)" ::: "memory"); __builtin_amdgcn_s_barrier(); asm volatile("" ::: "memory");
#pragma unroll
        for (int bj = 0; bj < 2; ++bj) { const int cc = col0 + bj * HALF;
            f32x4 gs0 = *(const f32x4*)(g + cc), gs1 = *(const f32x4*)(g + cc + 4), sh0 = {0.f, 0.f, 0.f, 0.f}, sh1 = sh0;
            if constexpr (MODE == 0) { gs0 = gs0 * (1.0f + *(const f32x4*)(sc + modrow * 12288 + cc)); gs1 = gs1 * (1.0f + *(const f32x4*)(sc + modrow * 12288 + cc + 4));
                sh0 = *(const f32x4*)(sh + modrow * 12288 + cc); sh1 = *(const f32x4*)(sh + modrow * 12288 + cc + 4); }
#pragma unroll
            for (int ai = 0; ai < 2; ++ai)
#pragma unroll
                for (int m = 0; m < 4; ++m) { const int r = ai * HALF + wr * 64 + m * 16 + fr; const float rs = S[r]; const size_t off = (size_t)(u.pm * BM + r) * 2048 + cc;
                    const f32x4 h0 = acc[ai][bj][m][0], h1 = acc[ai][bj][m][1];
                    if constexpr (MODE == 0) {
                        const f32x4 y0 = h0 * rs * gs0 + sh0, y1 = h1 * rs * gs1 + sh1;
                        u32x4 x; x.x = cvt_pk_bf16(y0[0], y0[1]); x.y = cvt_pk_bf16(y0[2], y0[3]); x.z = cvt_pk_bf16(y1[0], y1[1]); x.w = cvt_pk_bf16(y1[2], y1[3]);
                        *(u32x4*)(XNout + off) = x; }
                    else { *(f32x4*)(Fout + off) = h0 * rs * gs0; *(f32x4*)(Fout + off + 4) = h1 * rs * gs1; }
                    if (m & 1) asm volatile("" ::: "memory"); } }
    }
};
struct PanelOrder {
    int nM, G, c;
    __device__ bool next(int i, Unit& u) const { const int x = c & 7, j = c >> 3; u.ks = 0;
        if (i < 2) { u.pm = i * 32 + 4 * x + (j >> 3); u.pn = j & 7; return u.pm < nM; }
        if (i == 2 && nM > 64 && c < 64 && x < 4) { u.pm = 64 + x; u.pn = j; return true; }
        return false; }
    __device__ __forceinline__ void a_ready(const Unit&) const {}
    __device__ __forceinline__ void done(const Unit&) const {}
};
template <class Epi, class Sched, bool ALIGN_EPI = false, bool SP2 = false>
__device__ __forceinline__ void gemm_phase(PG8_LAS unsigned char* lds, const Gemm g, const Sched& S, const Epi& E) {
    int tid_ = threadIdx.x; asm volatile("" : "+v"(tid_));
    const int tid = tid_, wid = __builtin_amdgcn_readfirstlane(tid >> 6), lane = tid & 63, wr = wid >> 2, wc = wid & 3, fr = lane & 15, fq = lane >> 4;
    const int K = g.ld, nt = g.K / BK;
    const size_t kslice = (size_t)g.K * 2;
    unsigned voffA[2], voffB[2];
#pragma unroll
    for (int i = 0; i < 2; ++i) { int R, C; stage_rc(tid * 16 + i * 8192, R, C); const int Rb = Epi::PERM ? ((R & ~31) + perm32(R & 31)) : R;
        voffA[i] = (unsigned)(R * K + C) * 2u; voffB[i] = (unsigned)(Rb * K + C) * 2u; }
    const size_t kstep = (size_t)(BK * 2);
    const size_t hstep = (size_t)HALF * K * 2;
    const size_t tstep = 2 * hstep;
    const unsigned ldsw = (unsigned)wid * 1024u;
    const int aoff = lds_byte(wr * 64 + fr, fq * 8), boff = lds_byte(wc * 32 + fr, fq * 8);
#define PG8_SA(b, h) (((b) * 2 + (h)) * HTB)
#define PG8_SB(b, h) ((4 + (b) * 2 + (h)) * HTB)
#define PG8_STAGE(bufoff, gbase, voff) do { _Pragma("unroll") for (int _i = 0; _i < 2; ++_i) \
        __builtin_amdgcn_global_load_lds((const unsigned*)((const char*)(gbase) + (voff)[_i]), (PG8_LAS unsigned*)(lds + (bufoff) + ldsw + _i * 8192), 16, 0, 0); } while (0)
#define PG8_LDA(dst, b, h) do { _Pragma("unroll") for (int m = 0; m < 4; ++m) _Pragma("unroll") for (int k = 0; k < 2; ++k) dst[m][k] = *(const PG8_LAS bf16x8*)(lds + PG8_SA(b, h) + aoff + m * 2048 + k * 1024); } while (0)
#define PG8_LDB(dst, b, h) do { _Pragma("unroll") for (int n = 0; n < 2; ++n) _Pragma("unroll") for (int k = 0; k < 2; ++k) dst[n][k] = *(const PG8_LAS bf16x8*)(lds + PG8_SB(b, h) + boff + n * 2048 + k * 1024); } while (0)
#define PG8_MMA(ai, bj, At, Bt) do { __builtin_amdgcn_s_setprio(1); _Pragma("unroll") for (int m = 0; m < 4; ++m) _Pragma("unroll") for (int n = 0; n < 2; ++n) _Pragma("unroll") for (int k = 0; k < 2; ++k) \
        acc[ai][bj][m][n] = __builtin_amdgcn_mfma_f32_16x16x32_bf16(Bt[n][k], At[m][k], acc[ai][bj][m][n], 0, 0, 0); __builtin_amdgcn_s_setprio(0); } while (0)
#define PG8_WAIT_V(n) asm volatile("s_waitcnt vmcnt(" #n ")" ::: "memory")
#define PG8_WAIT_L(n) asm volatile("s_waitcnt lgkmcnt(" #n ")" ::: "memory")
#define PG8_BAR __builtin_amdgcn_s_barrier()
#define PG8_SCHED __builtin_amdgcn_sched_barrier(0)
    Unit cur, nxt; int ui = 0;
    if (!S.next(0, cur)) return;
    f32x4 acc[2][2][4][2];
#pragma unroll
    for (int a = 0; a < 2; ++a)
#pragma unroll
        for (int b = 0; b < 2; ++b)
#pragma unroll
            for (int m = 0; m < 4; ++m)
#pragma unroll
                for (int n = 0; n < 2; ++n) acc[a][b][m][n] = (f32x4){0.f, 0.f, 0.f, 0.f};
    bf16x8 At[4][2], B0[2][2], B1[2][2];
    const char* cA = (const char*)g.A + (size_t)cur.pm * tstep + (size_t)cur.ks * kslice; const char* cB = (const char*)g.Bt + (size_t)cur.pn * tstep + (size_t)cur.ks * kslice;
    S.a_ready(cur);
    if constexpr (SP2) {
        PG8_STAGE(PG8_SB(0, 0), cB, voffB); PG8_STAGE(PG8_SB(0, 1), cB + hstep, voffB); PG8_STAGE(PG8_SA(0, 0), cA, voffA); PG8_STAGE(PG8_SA(0, 1), cA + hstep, voffA);
        if (wr == 1) PG8_BAR;
        PG8_WAIT_V(2); PG8_BAR;
        PG8_STAGE(PG8_SB(1, 0), cB + kstep, voffB); PG8_STAGE(PG8_SA(1, 0), cA + kstep, voffA); PG8_STAGE(PG8_SB(1, 1), cB + hstep + kstep, voffB);
        PG8_WAIT_V(6); PG8_BAR;
    } else {
        PG8_STAGE(PG8_SB(0, 0), cB, voffB); PG8_STAGE(PG8_SA(0, 0), cA, voffA); PG8_STAGE(PG8_SB(0, 1), cB + hstep, voffB); PG8_STAGE(PG8_SA(0, 1), cA + hstep, voffA);
        if (wr == 1) PG8_BAR;
        PG8_WAIT_V(4); PG8_BAR;
        PG8_STAGE(PG8_SB(1, 0), cB + kstep, voffB); PG8_STAGE(PG8_SA(1, 0), cA + kstep, voffA); PG8_STAGE(PG8_SB(1, 1), cB + hstep + kstep, voffB);
        PG8_WAIT_V(6); PG8_BAR;
    }
    for (;;) {
        const bool has_next = S.next(ui + 1, nxt);
        const char* nA = has_next ? (const char*)g.A + (size_t)nxt.pm * tstep + (size_t)nxt.ks * kslice : cA; const char* nB = has_next ? (const char*)g.Bt + (size_t)nxt.pn * tstep + (size_t)nxt.ks * kslice : cB;
        for (int t = 0; t < nt; t += 2) {
            const bool last = (t == nt - 2);
            const char* a1 = cA + (size_t)(t + 1) * kstep;
            const char* a2 = last ? nA : cA + (size_t)(t + 2) * kstep; const char* b2 = last ? nB : cB + (size_t)(t + 2) * kstep;
            const char* a3 = a2 + kstep; const char* b3 = b2 + kstep;
            if (last && has_next) S.a_ready(nxt);
            if constexpr (SP2) {
            PG8_LDB(B0, 0, 0); PG8_LDB(B1, 0, 1); PG8_SCHED; PG8_LDA(At, 0, 0); PG8_STAGE(PG8_SA(1, 1), a1 + hstep, voffA);
            PG8_WAIT_V(8); PG8_WAIT_L(0); PG8_BAR; PG8_MMA(0, 0, At, B0); PG8_MMA(0, 1, At, B1); PG8_BAR; PG8_SCHED;
            PG8_LDA(At, 0, 1); PG8_STAGE(PG8_SB(0, 0), b2, voffB); PG8_STAGE(PG8_SB(0, 1), b2 + hstep, voffB); PG8_STAGE(PG8_SA(0, 0), a2, voffA);
            PG8_WAIT_V(8); PG8_WAIT_L(0); PG8_BAR; PG8_MMA(1, 0, At, B0); PG8_MMA(1, 1, At, B1); PG8_BAR; PG8_SCHED;
            PG8_LDB(B0, 1, 0); PG8_LDB(B1, 1, 1); PG8_SCHED; PG8_LDA(At, 1, 0); PG8_STAGE(PG8_SA(0, 1), a2 + hstep, voffA);
            PG8_WAIT_V(8); PG8_WAIT_L(0); PG8_BAR; PG8_MMA(0, 0, At, B0); PG8_MMA(0, 1, At, B1); PG8_BAR; PG8_SCHED;
            PG8_LDA(At, 1, 1); PG8_STAGE(PG8_SB(1, 0), b3, voffB); PG8_STAGE(PG8_SB(1, 1), b3 + hstep, voffB); PG8_STAGE(PG8_SA(1, 0), a3, voffA);
            PG8_WAIT_V(8); PG8_WAIT_L(0); PG8_BAR; PG8_MMA(1, 0, At, B0); PG8_MMA(1, 1, At, B1); PG8_BAR; PG8_SCHED;
            } else {
            PG8_LDB(B0, 0, 0); PG8_SCHED; PG8_LDA(At, 0, 0); PG8_STAGE(PG8_SA(1, 1), a1 + hstep, voffA);
            PG8_WAIT_L(8); PG8_BAR; PG8_WAIT_L(0); PG8_MMA(0, 0, At, B0); PG8_BAR; PG8_SCHED;
            PG8_LDB(B1, 0, 1); PG8_STAGE(PG8_SB(0, 0), b2, voffB);
            PG8_BAR; PG8_WAIT_L(0); PG8_MMA(0, 1, At, B1); PG8_BAR;
            PG8_LDA(At, 0, 1); PG8_STAGE(PG8_SA(0, 0), a2, voffA);
            PG8_BAR; PG8_WAIT_L(0); PG8_MMA(1, 0, At, B0); PG8_BAR; PG8_SCHED;
            PG8_STAGE(PG8_SB(0, 1), b2 + hstep, voffB);
            PG8_WAIT_V(6); PG8_BAR; PG8_MMA(1, 1, At, B1); PG8_BAR;
            PG8_LDB(B0, 1, 0); PG8_SCHED; PG8_LDA(At, 1, 0); PG8_STAGE(PG8_SA(0, 1), a2 + hstep, voffA);
            PG8_WAIT_L(8); PG8_BAR; PG8_WAIT_L(0); PG8_MMA(0, 0, At, B0); PG8_BAR; PG8_SCHED;
            PG8_LDB(B1, 1, 1); PG8_STAGE(PG8_SB(1, 0), b3, voffB);
            PG8_BAR; PG8_WAIT_L(0); PG8_MMA(0, 1, At, B1); PG8_BAR;
            PG8_LDA(At, 1, 1); PG8_STAGE(PG8_SA(1, 0), a3, voffA);
            PG8_BAR; PG8_WAIT_L(0); PG8_MMA(1, 0, At, B0); PG8_BAR; PG8_SCHED;
            PG8_STAGE(PG8_SB(1, 1), b3 + hstep, voffB);
            PG8_WAIT_V(6); PG8_BAR; PG8_MMA(1, 1, At, B1); PG8_BAR;
            }
        }
        if constexpr (ALIGN_EPI) { if (wr == 0) PG8_BAR; }
        if constexpr (!Epi::AFTER_DRAIN) { E(acc, cur, wr, wc, fr, fq); S.done(cur); }
        if (!has_next) break;
#pragma unroll
        for (int a = 0; a < 2; ++a)
#pragma unroll
            for (int b = 0; b < 2; ++b)
#pragma unroll
                for (int m = 0; m < 4; ++m)
#pragma unroll
                    for (int n = 0; n < 2; ++n) acc[a][b][m][n] = (f32x4){0.f, 0.f, 0.f, 0.f};
        cur = nxt; cA = nA; cB = nB; ++ui;
        if constexpr (ALIGN_EPI) { if (wr == 1) PG8_BAR; }
    }
    PG8_WAIT_V(0);
    if constexpr (!ALIGN_EPI) { if (wr == 0) PG8_BAR; }
    PG8_BAR;
    if constexpr (Epi::AFTER_DRAIN) { E.fused(acc, cur, wr, wc, fr, fq, lds, wid, lane); S.done(cur); }
#undef PG8_SA
#undef PG8_SB
#undef PG8_STAGE
#undef PG8_LDA
#undef PG8_LDB
#undef PG8_MMA
#undef PG8_WAIT_V
#undef PG8_WAIT_L
#undef PG8_BAR
#undef PG8_SCHED
}
}

namespace att {
typedef unsigned short bf16_t;
using bf16x8 = __attribute__((ext_vector_type(8))) short;
using s16x4  = __attribute__((ext_vector_type(4))) short;
using f32x16 = __attribute__((ext_vector_type(16))) float;
using u32x4  = __attribute__((ext_vector_type(4))) unsigned;
constexpr int D = 128, NW = 8, QBLK = 32, KVBLK = 64;
constexpr float SCALE = 0.088388347648318440f;
constexpr float THR = 8.f;
#ifndef ATT_SDEPTH
#define ATT_SDEPTH 2
#endif
#ifndef ATT_QKB
#define ATT_QKB 1
#endif
#ifndef ATT_PVB
#define ATT_PVB 1
#endif
constexpr int SDEPTH = ATT_SDEPTH;
constexpr size_t SHM_V = KVBLK * D * 2, SHM_K = KVBLK * D * 2, SHM_ATTN = 2 * SHM_V + 2 * SHM_K + NW * 64 * 4;
#define KSWZ(row, colB) ((row) * 256 + ((colB) ^ (((row) & 7) << 4)))
#define SBAR() __builtin_amdgcn_sched_barrier(0)
__device__ __forceinline__ int crow(int r, int hi) { return (r & 3) + 8 * (r >> 2) + 4 * hi; }
__device__ __forceinline__ unsigned cvtpk(float lo, float hi) { unsigned r; asm volatile("v_cvt_pk_bf16_f32 %0, %1, %2" : "=v"(r) : "v"(lo), "v"(hi)); return r; }
__device__ __forceinline__ float bf2f(short s) { return __uint_as_float(((unsigned)(unsigned short)s) << 16); }

__device__ __forceinline__ void partialSM(f32x16& p0, f32x16& p1, float& m_reg, float& mn, float& alpha) {
  constexpr float C = SCALE * 1.4426950408889634f;
  float pmax = p0[0]; for (int r = 1; r < 16; ++r) pmax = fmaxf(pmax, p0[r]); for (int r = 0; r < 16; ++r) pmax = fmaxf(pmax, p1[r]);
  { auto rr = __builtin_amdgcn_permlane32_swap(__float_as_uint(pmax), __float_as_uint(pmax), false, false);
    pmax = fmaxf(__uint_as_float(rr[0]), __uint_as_float(rr[1])); }
  if (__builtin_expect(__all(pmax - m_reg <= THR / SCALE), 1)) { mn = m_reg; alpha = 1.f; }
  else { mn = fmaxf(m_reg, pmax); alpha = __builtin_amdgcn_exp2f((m_reg - mn) * C); m_reg = mn; }
  float mnC = -mn * C;
  for (int r = 0; r < 16; ++r) p0[r] = fmaf(p0[r], C, mnC); for (int r = 0; r < 16; ++r) p1[r] = fmaf(p1[r], C, mnC);
  for (int r = 0; r < 16; ++r) p0[r] = __builtin_amdgcn_exp2f(p0[r]);
}
__device__ __forceinline__ void smfix(f32x16& p0, f32x16& p1, float nB) {
  constexpr float C = SCALE * 1.4426950408889634f;
  for (int r = 0; r < 16; ++r) p0[r] = fmaf(p0[r], C, nB); for (int r = 0; r < 16; ++r) p1[r] = fmaf(p1[r], C, nB);
  for (int r = 0; r < 16; ++r) p0[r] = __builtin_amdgcn_exp2f(p0[r]);
}
__device__ __forceinline__ void finishSM(f32x16& p0, f32x16& p1, float alpha, float& l_reg, bf16x8& pa0, bf16x8& pa1, bf16x8& pa2, bf16x8& pa3) {
  for (int r = 0; r < 16; ++r) p1[r] = __builtin_amdgcn_exp2f(p1[r]);
  float ps = 0; for (int r = 0; r < 16; ++r) ps += p0[r]; for (int r = 0; r < 16; ++r) ps += p1[r];
  { auto rr = __builtin_amdgcn_permlane32_swap(__float_as_uint(ps), __float_as_uint(ps), false, false);
    ps = __uint_as_float(rr[0]) + __uint_as_float(rr[1]); }
  l_reg = l_reg * alpha + ps;
#define PK4(P, BASE, OUT) do { unsigned a0 = cvtpk(P[BASE + 0], P[BASE + 1]), a1 = cvtpk(P[BASE + 2], P[BASE + 3]);   \
    unsigned b0 = cvtpk(P[BASE + 4], P[BASE + 5]), b1 = cvtpk(P[BASE + 6], P[BASE + 7]);                              \
    auto r0 = __builtin_amdgcn_permlane32_swap(a0, b0, false, false); auto r1 = __builtin_amdgcn_permlane32_swap(a1, b1, false, false); \
    u32x4 w = {r0[0], r1[0], r0[1], r1[1]}; OUT = *reinterpret_cast<bf16x8*>(&w); } while (0)
  PK4(p0, 0, pa0); PK4(p0, 8, pa1); PK4(p1, 0, pa2); PK4(p1, 8, pa3);
#undef PK4
}
__device__ __forceinline__ void qkt(f32x16& p0, f32x16& p1, const char* Ks, const bf16x8* qr, int r32, int hi) {
  p0 = f32x16{}; p1 = f32x16{};
#if ATT_QKB == 1
  for (int d0 = 0; d0 < 8; ++d0) { int cb = (d0 * 16 + hi * 8) * 2;
    bf16x8 b0 = *reinterpret_cast<const bf16x8*>(Ks + KSWZ(r32, cb));
    bf16x8 b1 = *reinterpret_cast<const bf16x8*>(Ks + KSWZ(32 + r32, cb));
    p0 = __builtin_amdgcn_mfma_f32_32x32x16_bf16(b0, qr[d0], p0, 0, 0, 0);
    p1 = __builtin_amdgcn_mfma_f32_32x32x16_bf16(b1, qr[d0], p1, 0, 0, 0); }
#else
#pragma unroll
  for (int d0 = 0; d0 < 8; d0 += ATT_QKB) { bf16x8 b0[ATT_QKB], b1[ATT_QKB];
#pragma unroll
    for (int t = 0; t < ATT_QKB; ++t) { const int cb = ((d0 + t) * 16 + hi * 8) * 2;
      b0[t] = *reinterpret_cast<const bf16x8*>(Ks + KSWZ(r32, cb)); b1[t] = *reinterpret_cast<const bf16x8*>(Ks + KSWZ(32 + r32, cb)); }
    asm volatile("s_waitcnt lgkmcnt(0)" ::: "memory"); SBAR();
#pragma unroll
    for (int t = 0; t < ATT_QKB; ++t) { p0 = __builtin_amdgcn_mfma_f32_32x32x16_bf16(b0[t], qr[d0 + t], p0, 0, 0, 0); p1 = __builtin_amdgcn_mfma_f32_32x32x16_bf16(b1[t], qr[d0 + t], p1, 0, 0, 0); }
    SBAR(); }
#endif
}
__device__ __forceinline__ int v_st(int k, int c) { const int kk = (k & ~0xC) | ((k & 4) << 1) | ((k & 8) >> 1); return ((kk >> 3) * 4 + (c >> 5)) * 512 + ((kk & 7) * 32 + (c & 31)) * 2; }
__device__ __forceinline__ int v_rd_base(int lane) { return ((lane & 3) << 3) | (((lane >> 2) & 3) << 6) | (((lane >> 4) & 1) << 5) | (((lane >> 5) & 1) << 8); }
constexpr int v_rd_off(int d0, int ks, int half) { return d0 * 512 + ks * 4096 + half * 2048; }
template <int OFF> __device__ __forceinline__ s16x4 tr_read(int vb) {
  s16x4 r; asm volatile("ds_read_b64_tr_b16 %0, %1 offset:%2" : "=&v"(r) : "v"(vb), "i"(OFF) : "memory"); return r;
}
template <int D0> __device__ __forceinline__ void pv_one(f32x16& od, int vb, bf16x8 pa0, bf16x8 pa1, bf16x8 pa2, bf16x8 pa3) {
  const s16x4 l0 = tr_read<v_rd_off(D0, 0, 0)>(vb), h0 = tr_read<v_rd_off(D0, 0, 1)>(vb), l1 = tr_read<v_rd_off(D0, 1, 0)>(vb), h1 = tr_read<v_rd_off(D0, 1, 1)>(vb);
  const s16x4 l2 = tr_read<v_rd_off(D0, 2, 0)>(vb), h2 = tr_read<v_rd_off(D0, 2, 1)>(vb), l3 = tr_read<v_rd_off(D0, 3, 0)>(vb), h3 = tr_read<v_rd_off(D0, 3, 1)>(vb);
  asm volatile("s_waitcnt lgkmcnt(0)" ::: "memory"); SBAR();
#define PK(L, H) (bf16x8){L[0], L[1], L[2], L[3], H[0], H[1], H[2], H[3]}
  od = __builtin_amdgcn_mfma_f32_32x32x16_bf16(pa0, PK(l0, h0), od, 0, 0, 0);
  od = __builtin_amdgcn_mfma_f32_32x32x16_bf16(pa1, PK(l1, h1), od, 0, 0, 0);
  od = __builtin_amdgcn_mfma_f32_32x32x16_bf16(pa2, PK(l2, h2), od, 0, 0, 0);
  od = __builtin_amdgcn_mfma_f32_32x32x16_bf16(pa3, PK(l3, h3), od, 0, 0, 0);
#undef PK
}
template <int D0> __device__ __forceinline__ void pv_two(f32x16& oa, f32x16& ob, int vb, bf16x8 pa0, bf16x8 pa1, bf16x8 pa2, bf16x8 pa3) {
  const s16x4 l0 = tr_read<v_rd_off(D0, 0, 0)>(vb), h0 = tr_read<v_rd_off(D0, 0, 1)>(vb), l1 = tr_read<v_rd_off(D0, 1, 0)>(vb), h1 = tr_read<v_rd_off(D0, 1, 1)>(vb);
  const s16x4 l2 = tr_read<v_rd_off(D0, 2, 0)>(vb), h2 = tr_read<v_rd_off(D0, 2, 1)>(vb), l3 = tr_read<v_rd_off(D0, 3, 0)>(vb), h3 = tr_read<v_rd_off(D0, 3, 1)>(vb);
  const s16x4 m0 = tr_read<v_rd_off(D0 + 1, 0, 0)>(vb), g0 = tr_read<v_rd_off(D0 + 1, 0, 1)>(vb), m1 = tr_read<v_rd_off(D0 + 1, 1, 0)>(vb), g1 = tr_read<v_rd_off(D0 + 1, 1, 1)>(vb);
  const s16x4 m2 = tr_read<v_rd_off(D0 + 1, 2, 0)>(vb), g2 = tr_read<v_rd_off(D0 + 1, 2, 1)>(vb), m3 = tr_read<v_rd_off(D0 + 1, 3, 0)>(vb), g3 = tr_read<v_rd_off(D0 + 1, 3, 1)>(vb);
  asm volatile("s_waitcnt lgkmcnt(0)" ::: "memory"); SBAR();
#define PK(L, H) (bf16x8){L[0], L[1], L[2], L[3], H[0], H[1], H[2], H[3]}
  oa = __builtin_amdgcn_mfma_f32_32x32x16_bf16(pa0, PK(l0, h0), oa, 0, 0, 0);
  ob = __builtin_amdgcn_mfma_f32_32x32x16_bf16(pa0, PK(m0, g0), ob, 0, 0, 0);
  oa = __builtin_amdgcn_mfma_f32_32x32x16_bf16(pa1, PK(l1, h1), oa, 0, 0, 0);
  ob = __builtin_amdgcn_mfma_f32_32x32x16_bf16(pa1, PK(m1, g1), ob, 0, 0, 0);
  oa = __builtin_amdgcn_mfma_f32_32x32x16_bf16(pa2, PK(l2, h2), oa, 0, 0, 0);
  ob = __builtin_amdgcn_mfma_f32_32x32x16_bf16(pa2, PK(m2, g2), ob, 0, 0, 0);
  oa = __builtin_amdgcn_mfma_f32_32x32x16_bf16(pa3, PK(l3, h3), oa, 0, 0, 0);
  ob = __builtin_amdgcn_mfma_f32_32x32x16_bf16(pa3, PK(m3, g3), ob, 0, 0, 0);
#undef PK
}
__device__ __forceinline__ void pv_d0(f32x16* o, int vb, bf16x8 pa0, bf16x8 pa1, bf16x8 pa2, bf16x8 pa3) {
#if ATT_PVB == 2
  pv_two<0>(o[0], o[1], vb, pa0, pa1, pa2, pa3); pv_two<2>(o[2], o[3], vb, pa0, pa1, pa2, pa3);
#else
  pv_one<0>(o[0], vb, pa0, pa1, pa2, pa3); pv_one<1>(o[1], vb, pa0, pa1, pa2, pa3); pv_one<2>(o[2], vb, pa0, pa1, pa2, pa3); pv_one<3>(o[3], vb, pa0, pa1, pa2, pa3);
#endif
}
__device__ __forceinline__ void wmask(f32x16& p0, f32x16& p1, int kb, int qpos, int hi) {
#pragma unroll
  for (int r = 0; r < 16; ++r) { const int k0 = kb + crow(r, hi), k1 = k0 + 32;
    const bool ok0 = (unsigned)(k0 - qpos + 128) <= 256u && (unsigned)k0 < 4096u, ok1 = (unsigned)(k1 - qpos + 128) <= 256u && (unsigned)k1 < 4096u;
    p0[r] = ok0 ? p0[r] : -1e30f; p1[r] = ok1 ? p1[r] : -1e30f; }
}
struct UnitArgs {
  int qrow0;
  int qcol;
  int kvbase;
  int kstart;
  int NT;
  int tpos0;
  int rope;
  int ocol;
  float sinkl2;
  float nB;
  int has_sink;
};
template <int LDP, bool WINDOW, bool FIXED>
__device__ __forceinline__ void attn_unit(const bf16_t* __restrict__ P, const bf16_t* __restrict__ KC, const bf16_t* __restrict__ VC, bf16_t* __restrict__ CAT, const float* qg, const UnitArgs a, char* lds) {
  constexpr int SD = FIXED ? 1 : SDEPTH;
  int tid_ = threadIdx.x; asm volatile("" : "+v"(tid_));
  { __attribute__((address_space(1))) const float* qg1 = (__attribute__((address_space(1))) const float*)qg; asm volatile("" : "+s"(qg1)); qg = (const float*)qg1; }
  const int tid = tid_, wid = tid >> 6, lane = tid & 63, r32 = lane & 31, hi = lane >> 5;
  char* V_lds = lds; char* K_lds = lds + 3 * SHM_V;
  float* ws = (float*)(lds + 3 * SHM_V + 3 * SHM_K) + wid * 64; float* li_l = ws; float* al_l = ws + 32;
  float m_reg = -1e30f, l_reg = 0; f32x16 o[4] = {}; bf16x8 qr[8];
  const int qpos = a.tpos0 + wid * QBLK + r32;
  const int sr = tid >> 4, sc = (tid & 15) * 8, vst0 = v_st(sr, sc), vst1 = v_st(32 + sr, sc);
  const int vb0 = (int)(uintptr_t)V_lds + v_rd_base(lane);
  struct { bf16x8 vs0, vs1, ks0, ks1; } sr_[SD];
  const bf16_t* Kc = KC + a.kvbase + sc; const bf16_t* Vc = VC + a.kvbase + sc;
#define TROW(jt) ((jt) < 4 ? 64 * (jt) : max(256 + a.kstart + 64 * ((jt) - 4), 0))
#define SLOAD(i, jt) do { const size_t _r0 = (size_t)(TROW(jt) + sr) * 128; const size_t _r1 = _r0 + (size_t)32 * 128; \
    sr_[i].vs0 = *reinterpret_cast<const bf16x8*>(Vc + _r0); sr_[i].vs1 = *reinterpret_cast<const bf16x8*>(Vc + _r1); \
    sr_[i].ks0 = *reinterpret_cast<const bf16x8*>(Kc + _r0); sr_[i].ks1 = *reinterpret_cast<const bf16x8*>(Kc + _r1); } while (0)
  SLOAD(0, 0);
  {
    const bf16_t* Qw = P + (size_t)(a.qrow0 + wid * QBLK + r32) * LDP + a.qcol + hi * 8;
    bf16x8 raw[8];
#pragma unroll
    for (int d0 = 0; d0 < 8; ++d0) raw[d0] = *reinterpret_cast<const bf16x8*>(Qw + d0 * 16);
    float ss = 0.f;
#pragma unroll
    for (int d0 = 0; d0 < 8; ++d0)
#pragma unroll
      for (int e = 0; e < 8; ++e) { const float f = bf2f(raw[d0][e]); ss += f * f; }
    { auto rr = __builtin_amdgcn_permlane32_swap(__float_as_uint(ss), __float_as_uint(ss), false, false); ss = __uint_as_float(rr[0]) + __uint_as_float(rr[1]); }
    const float rstd = 1.0f / sqrtf(ss * (1.0f / 128.0f) + 1e-6f);
    const float pr = (float)(qpos >> 6), pc = (float)(qpos & 63);
#pragma unroll
    for (int ax = 0; ax < 2; ++ax)
#pragma unroll
      for (int dd = 0; dd < 2; ++dd) { const int da = ax * 4 + dd, db = da + 2; float x1[8], x2[8];
        const float* ga = qg + da * 16 + hi * 8; const float* gb = qg + db * 16 + hi * 8;
#pragma unroll
        for (int e = 0; e < 8; ++e) { x1[e] = bf2f(raw[da][e]) * rstd * ga[e]; x2[e] = bf2f(raw[db][e]) * rstd * gb[e]; }
        if (a.rope) { const float pos = ax == 0 ? pr : pc;
#pragma unroll
          for (int e = 0; e < 8; ++e) { const int i = dd * 16 + hi * 8 + e; const float inv = __builtin_amdgcn_exp2f(-(float)i * 0.41524101186092029f);
            const float an = pos * inv, c = __cosf(an), s = __sinf(an), y1 = x1[e] * c - x2[e] * s, y2 = x2[e] * c + x1[e] * s; x1[e] = y1; x2[e] = y2; } }
        { u32x4 w = {cvtpk(x1[0], x1[1]), cvtpk(x1[2], x1[3]), cvtpk(x1[4], x1[5]), cvtpk(x1[6], x1[7])}; qr[da] = *reinterpret_cast<bf16x8*>(&w); }
        { u32x4 w = {cvtpk(x2[0], x2[1]), cvtpk(x2[2], x2[3]), cvtpk(x2[4], x2[5]), cvtpk(x2[6], x2[7])}; qr[db] = *reinterpret_cast<bf16x8*>(&w); }
        asm volatile("" ::: "memory"); }
  }
#define SWRITE(b, i) do { *(bf16x8*)(V_lds + (b) * SHM_V + vst0) = sr_[i].vs0;          \
    *(bf16x8*)(V_lds + (b) * SHM_V + vst1) = sr_[i].vs1; int kc = sc * 2;               \
    *(bf16x8*)(K_lds + (b) * SHM_K + KSWZ(sr, kc)) = sr_[i].ks0;                       \
    *(bf16x8*)(K_lds + (b) * SHM_K + KSWZ(32 + sr, kc)) = sr_[i].ks1; } while (0)
#define SWAIT() do { if constexpr (SD == 2) asm volatile("s_waitcnt vmcnt(4)" ::: "memory"); else asm volatile("s_waitcnt vmcnt(0)" ::: "memory"); } while (0)
#define RESC(al) do { if (__any((al) < 1.f)) { if (hi == 0) al_l[r32] = (al); asm volatile("s_waitcnt lgkmcnt(0)" ::: "memory"); \
    for (int d = 0; d < 4; ++d) for (int r = 0; r < 16; ++r) o[d][r] *= al_l[crow(r, hi)]; } } while (0)
#define WMASK(p0, p1, jt) do { if constexpr (WINDOW) { if ((jt) >= 4) wmask(p0, p1, a.kstart + 64 * ((jt) - 4), qpos, hi); } } while (0)
#define PSM(q0, q1, mnx, alx) do { if constexpr (FIXED) { smfix(q0, q1, a.nB); alx = 1.f; } else partialSM(q0, q1, m_reg, mnx, alx); } while (0)
  f32x16 pA0, pA1, pB0, pB1; float mnA, mnB, alA, alB; bf16x8 pa0, pa1, pa2, pa3; const int NT = a.NT;
  constexpr int SE = 0, SO = SD - 1;
  asm volatile("s_waitcnt vmcnt(0)" ::: "memory"); SWRITE(0, SE); __syncthreads();
  qkt(pA0, pA1, K_lds, qr, r32, hi); PSM(pA0, pA1, mnA, alA);
  SLOAD(SO, 1); if constexpr (SD == 2) { if (2 < NT) SLOAD(SE, 2); }
  SWAIT(); SWRITE(1, SO); __syncthreads();
  int bprev = 0, bcur = 1, bnext = 2;
#define ROT() do { bprev = bcur; bcur = bnext; bnext = (bnext == 2) ? 0 : bnext + 1; } while (0)
  for (int j = 1; j + 1 < NT; j += 2) {
    SBAR(); qkt(pB0, pB1, K_lds + bcur * (int)SHM_K, qr, r32, hi);
    finishSM(pA0, pA1, alA, l_reg, pa0, pa1, pa2, pa3); SBAR();
    SLOAD(SO, j + SD); SBAR();
    pv_d0(o, vb0 + bprev * (int)SHM_V, pa0, pa1, pa2, pa3); WMASK(pB0, pB1, j); PSM(pB0, pB1, mnB, alB);
    SWAIT(); SWRITE(bnext, SE);
    if constexpr (!FIXED) RESC(alB); __syncthreads(); ROT();
    SBAR(); qkt(pA0, pA1, K_lds + bcur * (int)SHM_K, qr, r32, hi);
    finishSM(pB0, pB1, alB, l_reg, pa0, pa1, pa2, pa3); SBAR();
    if (SD == 1 || j + 3 < NT) SLOAD(SE, j + 1 + SD); SBAR();
    pv_d0(o, vb0 + bprev * (int)SHM_V, pa0, pa1, pa2, pa3); WMASK(pA0, pA1, j + 1); PSM(pA0, pA1, mnA, alA);
    SWAIT(); SWRITE(bnext, SO);
    if constexpr (!FIXED) RESC(alA); __syncthreads(); ROT();
  }
  SBAR(); qkt(pB0, pB1, K_lds + bcur * (int)SHM_K, qr, r32, hi);
  finishSM(pA0, pA1, alA, l_reg, pa0, pa1, pa2, pa3); SBAR();
  pv_d0(o, vb0 + bprev * (int)SHM_V, pa0, pa1, pa2, pa3); WMASK(pB0, pB1, NT - 1); PSM(pB0, pB1, mnB, alB);
  if constexpr (!FIXED) RESC(alB);
  finishSM(pB0, pB1, alB, l_reg, pa0, pa1, pa2, pa3); SBAR();
  pv_d0(o, vb0 + bcur * (int)SHM_V, pa0, pa1, pa2, pa3);
#undef ROT
  if (a.has_sink) l_reg += __builtin_amdgcn_exp2f(FIXED ? a.sinkl2 + a.nB : a.sinkl2 - m_reg * (SCALE * 1.4426950408889634f));
#undef PSM
  if (hi == 0) li_l[r32] = l_reg; asm volatile("s_waitcnt lgkmcnt(0)" ::: "memory");
  float rli[16];
#pragma unroll
  for (int r = 0; r < 16; ++r) rli[r] = __builtin_amdgcn_rcpf(li_l[crow(r, hi)]);
  bf16_t* Ow = CAT + (size_t)(a.qrow0 + wid * QBLK) * 2048 + a.ocol + r32;
#pragma unroll
  for (int r = 0; r < 16; ++r) { const int orow = crow(r, hi);
#pragma unroll
    for (int d0 = 0; d0 < 4; ++d0) { const float v = o[d0][r] * rli[r]; Ow[(size_t)orow * 2048 + d0 * 32] = (bf16_t)(cvtpk(v, v) & 0xffffu); } }
#undef TROW
#undef SLOAD
#undef SWRITE
#undef SWAIT
#undef RESC
#undef WMASK
}
}

namespace cg = cooperative_groups;
typedef unsigned short bf16_t;
typedef float f32x4 __attribute__((ext_vector_type(4)));
typedef float f32x2 __attribute__((ext_vector_type(2)));
typedef unsigned u32x4 __attribute__((ext_vector_type(4)));
typedef unsigned u32x2 __attribute__((ext_vector_type(2)));
typedef short bf16x8 __attribute__((ext_vector_type(8)));
typedef short s16x4 __attribute__((ext_vector_type(4)));

constexpr int DM = 2048, SEQ = 4096, NB = 4, CTXL = 256, FFN = 5632, NMOD = 12288;
constexpr int MLAT = NB * SEQ, MCTX = NB * CTXL, MALL = MLAT + MCTX;
constexpr int LDP0 = 4096, LDP1 = 3072;
constexpr float EPS = 1e-6f;
constexpr size_t MiB = 1u << 20;
constexpr size_t WS_BAR = 512 * 1024, BAR_BYTES = 16384, WS_CNT = 640 * 1024, WS_CNTX = 768 * 1024, ZERO_BYTES = 1u << 20;
constexpr size_t WS_MOD = 0, WS_W0IN = 1 * MiB, WS_W0OUT = 17 * MiB, WS_W0GU = 25 * MiB, WS_W0DN = 69 * MiB, WS_W1IN = 91 * MiB, WS_W1OUT = 103 * MiB, WS_W1GU = 111 * MiB, WS_W1DN = 155 * MiB;
constexpr size_t WS_XN = 177 * MiB, WS_H = 245 * MiB, WS_PROJ = 381 * MiB, WS_CAT = 517 * MiB, WS_HID = WS_PROJ, WS_PP = 585 * MiB, WS_KC = 617 * MiB, WS_VC = 634 * MiB, WS_SSX = 652 * MiB, WS_END = 656 * MiB;
static_assert(WS_HID + (size_t)MALL * FFN * 2 <= WS_END && WS_CAT + (size_t)MALL * DM * 2 <= WS_END && WS_PROJ + (size_t)MALL * LDP0 * 2 <= WS_CAT, "ws map");
constexpr int NWAVES = 8, NTHR = 512;
constexpr int LDS_BYTES = 147456;

#define LAS __attribute__((address_space(3)))
#define XB_TMO      128
#define XB_XCNT(j)  (256  + 64 * (j))
#define XB_XSUB(j)  (1280 + 64 * (j))
#define XB_XGEN(j)  (2304 + 64 * (j))
#define XB_TOP      3328
#define XB_TOPGEN   3392
#define XCD_BAR_WORDS 3456
#define XB_SPIN_CAP (1u << 18)

__device__ __forceinline__ unsigned xb_ld(unsigned* p)              { return __hip_atomic_load(p, __ATOMIC_RELAXED, __HIP_MEMORY_SCOPE_AGENT); }
__device__ __forceinline__ unsigned xb_add(unsigned* p, unsigned v) { return __hip_atomic_fetch_add(p, v, __ATOMIC_RELAXED, __HIP_MEMORY_SCOPE_AGENT); }
__device__ __forceinline__ unsigned xb_xcc_id() { return (unsigned)__builtin_amdgcn_s_getreg((3 << 11) | 20) & 0xFu; }
#define XB_SPIN(cond, bar) do { unsigned _sp = 0; while (cond) { __builtin_amdgcn_s_sleep(1); \
    if ((++_sp & 255u) == 0u) { if (xb_ld(&(bar)[XB_TMO])) break; if (_sp > XB_SPIN_CAP) { atomicAdd(&(bar)[XB_TMO], 1u); break; } } } } while (0)

struct XcdBarrier {
    unsigned* bar; unsigned x;
    volatile LAS unsigned* st;
};

__device__ __forceinline__ XcdBarrier xcd_barrier_post(unsigned* bar, volatile LAS unsigned* st) {
    XcdBarrier b; b.bar = bar; b.x = xb_xcc_id(); b.st = st;
    if (threadIdx.x == 0) (void)xb_add(&bar[XB_XCNT(b.x)], 1u);
    return b;
}
__device__ __forceinline__ void xcd_barrier_complete(unsigned* bar, unsigned x, unsigned& nloc, unsigned& nx) {
    const unsigned G = gridDim.x * gridDim.y * gridDim.z;
    unsigned sum, cnt, mine, sp = 0u;
    for (;;) {
        sum = 0u; cnt = 0u; mine = 0u;
#pragma unroll
        for (unsigned j = 0; j < 16; ++j) { const unsigned c = xb_ld(&bar[XB_XCNT(j)]); sum += c; cnt += (c > 0u) ? 1u : 0u; mine = (j == x) ? c : mine; }
        if (sum == G) break;
        __builtin_amdgcn_s_sleep(1);
        if ((++sp & 255u) == 0u) { if (xb_ld(&bar[XB_TMO])) break; if (sp > XB_SPIN_CAP) { atomicAdd(&bar[XB_TMO], 1u); break; } }
    }
    nloc = mine > 0u ? mine : 1u; nx = cnt > 0u ? cnt : 1u;
}

__device__ __forceinline__ void xcd_barrier(const XcdBarrier& b) {
    asm volatile("s_waitcnt vmcnt(0)" ::: "memory");
    __syncthreads();
    if (threadIdx.x == 0) {
        unsigned* bar; { __attribute__((address_space(1))) unsigned* b1 = (__attribute__((address_space(1))) unsigned*)b.bar; asm volatile("" : "+s"(b1)); bar = (unsigned*)b1; }
        __builtin_amdgcn_s_waitcnt(0);
        unsigned nloc = b.st[0], nx = b.st[1];
        if (nloc == 0u) { unsigned bx0 = b.x; asm volatile("" : "+s"(bx0)); xcd_barrier_complete(bar, bx0, nloc, nx); b.st[0] = nloc; b.st[1] = nx; }
        unsigned bx = b.x; asm volatile("" : "+s"(bx));
        const unsigned old = xb_add(&bar[XB_XSUB(bx)], 1u);
        const unsigned gen = old / nloc;
        if (old + 1u == (gen + 1u) * nloc) {
            __builtin_amdgcn_fence(__ATOMIC_RELEASE, "agent");
            asm volatile("s_waitcnt vmcnt(0)" ::: "memory");
            const unsigned og = xb_add(&bar[XB_TOP], 1u);
            const unsigned tg = og / nx;
            if (og + 1u == (tg + 1u) * nx) xb_add(&bar[XB_TOPGEN], 1u);
            else XB_SPIN(xb_ld(&bar[XB_TOPGEN]) == tg, bar);
            __builtin_amdgcn_fence(__ATOMIC_ACQUIRE, "agent");
            xb_add(&bar[XB_XGEN(bx)], 1u);
            asm volatile("s_waitcnt vmcnt(0)" ::: "memory");
        } else {
            XB_SPIN(xb_ld(&bar[XB_XGEN(bx)]) == gen, bar);
            __builtin_amdgcn_fence(__ATOMIC_ACQUIRE, "agent");
            asm volatile("s_waitcnt vmcnt(0)" ::: "memory");
        }
    }
    __syncthreads();
}

struct Args {
  const float *x, *c, *ctx, *c_ctx;
  const float *l0_norm1_g, *l0_w_mod, *l0_b_mod, *l0_w_in, *l0_q_g, *l0_k_g, *l0_conv_w, *l0_w_out, *l0_norm2_g, *l0_w_gate, *l0_w_up, *l0_w_down;
  const float *l1_norm1_g, *l1_w_mod, *l1_b_mod, *l1_w_in, *l1_q_g, *l1_k_g, *l1_sink, *l1_pool_w, *l1_pool_scale, *l1_w_out, *l1_norm2_g, *l1_w_gate, *l1_w_up, *l1_w_down;
  const float *final_g;
  float* out; unsigned char* ws;
};

__device__ __forceinline__ float wave_sum(float v) {
#pragma unroll
  for (int o = 1; o < 64; o <<= 1) v += __shfl_xor(v, o);
  return v;
}
__device__ __forceinline__ unsigned pk2(float lo, float hi) { return pg8::cvt_pk_bf16(lo, hi); }
__device__ __forceinline__ float bf2f(unsigned short s) { return __uint_as_float(((unsigned)s) << 16); }
__device__ __forceinline__ float silu(float x) { return x / (1.0f + __expf(-x)); }

template <int MODE>
__device__ __forceinline__ void tr_item(const float* __restrict__ W, int N, bf16_t* __restrict__ WT, int ldk, int item, int lane) {
  const int nblk = N >> 6, kb = item / nblk, nb = item - kb * nblk, k0 = kb * 64, n = nb * 64 + lane;
  const int drow = MODE == 0 ? n : ((n >> 7) * 256 + (n & 127) + (MODE == 2 ? 128 : 0));
  const float* src = W + (size_t)k0 * N + n; bf16_t* dst = WT + (size_t)drow * ldk + k0;
  float v[64];
#pragma unroll
  for (int i = 0; i < 64; ++i) v[i] = __builtin_nontemporal_load(src + (size_t)i * N);
#pragma unroll
  for (int c = 0; c < 8; ++c) { u32x4 w; w.x = pk2(v[8 * c], v[8 * c + 1]); w.y = pk2(v[8 * c + 2], v[8 * c + 3]); w.z = pk2(v[8 * c + 4], v[8 * c + 5]); w.w = pk2(v[8 * c + 6], v[8 * c + 7]);
    *(u32x4*)(dst + c * 8) = w; }
}

template <bool PART, bool SRC_BF16>
__device__ __forceinline__ void norm_mod_rows(const void* __restrict__ src_lat, const void* __restrict__ src_ctx, int nrows, const float* __restrict__ g, const float* __restrict__ mod, int so, int sco,
                                              bf16_t* __restrict__ XN, int gw, int ngw, int lane, const float* __restrict__ part = nullptr, const float* __restrict__ pgate = nullptr, int row0 = 0) {
  asm volatile("" : "+v"(lane));
  for (int row = row0 + gw; row < nrows; row += ngw) {
    const size_t xoff = row < MLAT ? (size_t)row * DM : (size_t)(row - MLAT) * DM; const void* xb = row < MLAT ? src_lat : src_ctx;
    const float* mr = mod + (row < MLAT ? (row >> 12) : 4) * NMOD;
    f32x4 v[8]; float ss = 0.f;
#pragma unroll
    for (int j = 0; j < 8; ++j) {
      if constexpr (SRC_BF16) { const u32x2 w = ((const u32x2*)((const bf16_t*)xb + xoff))[lane + 64 * j]; v[j] = (f32x4){__uint_as_float(w.x << 16), __uint_as_float(w.x & 0xffff0000u), __uint_as_float(w.y << 16), __uint_as_float(w.y & 0xffff0000u)}; }
      else v[j] = ((const f32x4*)((const float*)xb + xoff))[lane + 64 * j];
      if (PART && row >= MLAT) { const float* pr = part + (size_t)(row - MLAT) * DM + 4 * (lane + 64 * j); const f32x4 ps = (*(const f32x4*)pr + *(const f32x4*)(pr + (size_t)1024 * DM)) + (*(const f32x4*)(pr + (size_t)2048 * DM) + *(const f32x4*)(pr + (size_t)3072 * DM));
        v[j] += *(const f32x4*)(pgate + 4 * (lane + 64 * j)) * ps; }
      ss += (v[j].x * v[j].x + v[j].y * v[j].y) + (v[j].z * v[j].z + v[j].w * v[j].w); }
    const float rstd = 1.0f / sqrtf(wave_sum(ss) * (1.0f / DM) + EPS);
    u32x2* o8 = (u32x2*)(XN + (size_t)row * DM) + lane;
#pragma unroll
    for (int j = 0; j < 8; ++j) { const int col = 4 * (lane + 64 * j); const f32x4 gg = *(const f32x4*)(g + col), sc = *(const f32x4*)(mr + sco + col), sh = *(const f32x4*)(mr + so + col);
      const f32x4 y = v[j] * rstd * gg * (1.0f + sc) + sh; u32x2 w; w.x = pk2(y.x, y.y); w.y = pk2(y.z, y.w); o8[64 * j] = w; }
  }
}
__device__ __forceinline__ void final_norm_rows(const float* H, const float* __restrict__ g, float* out, int gw, int ngw, int lane) {
  asm volatile("" : "+v"(lane));
  for (int row = gw; row < MLAT; row += ngw) {
    const float* xr = H + (size_t)row * DM; f32x4 v[8]; float ss = 0.f;
#pragma unroll
    for (int j = 0; j < 8; ++j) { v[j] = ((const f32x4*)xr)[lane + 64 * j]; ss += (v[j].x * v[j].x + v[j].y * v[j].y) + (v[j].z * v[j].z + v[j].w * v[j].w); }
    const float rstd = 1.0f / sqrtf(wave_sum(ss) * (1.0f / DM) + EPS);
    f32x4* o = (f32x4*)(out + (size_t)row * DM) + lane;
#pragma unroll
    for (int j = 0; j < 8; ++j) { const f32x4 gg = *(const f32x4*)(g + 4 * (lane + 64 * j)); o[64 * j] = v[j] * rstd * gg; }
  }
}
template <int LDP>
__device__ __forceinline__ void knorm_row(const bf16_t* __restrict__ P, bf16_t* __restrict__ KC, bf16_t* __restrict__ VC, int row, const float* __restrict__ kg, int lane) {
  const int head = lane >> 4, s = lane & 15, half = s >> 3, i4 = (s & 7) * 4, d1 = half * 64 + i4;
  const bf16_t* p = P + (size_t)row * LDP + 1536 + head * 128 + d1;
  const int kb = row < MLAT ? (row >> 12) : ((row - MLAT) >> 8), kpos = row < MLAT ? 256 + (row & (SEQ - 1)) : ((row - MLAT) & (CTXL - 1));
  const size_t kvo = ((size_t)(kb * 4 + head) * 4352 + kpos) * 128;
  const u32x2 a = *(const u32x2*)p, b = *(const u32x2*)(p + 32);
  float x1[4] = {__uint_as_float(a.x << 16), __uint_as_float(a.x & 0xffff0000u), __uint_as_float(a.y << 16), __uint_as_float(a.y & 0xffff0000u)};
  float x2[4] = {__uint_as_float(b.x << 16), __uint_as_float(b.x & 0xffff0000u), __uint_as_float(b.y << 16), __uint_as_float(b.y & 0xffff0000u)};
  float ss = 0.f;
#pragma unroll
  for (int e = 0; e < 4; ++e) ss += x1[e] * x1[e] + x2[e] * x2[e];
  ss += __shfl_xor(ss, 1); ss += __shfl_xor(ss, 2); ss += __shfl_xor(ss, 4); ss += __shfl_xor(ss, 8);
  const float rstd = 1.0f / sqrtf(ss * (1.0f / 128.0f) + EPS);
  const f32x4 g1 = *(const f32x4*)(kg + d1), g2 = *(const f32x4*)(kg + d1 + 32);
#pragma unroll
  for (int e = 0; e < 4; ++e) { x1[e] *= rstd * g1[e]; x2[e] *= rstd * g2[e]; }
  if (row < MLAT) {
    const int t = row & (SEQ - 1); const float pos = (float)(half == 0 ? (t >> 6) : (t & 63));
#pragma unroll
    for (int e = 0; e < 4; ++e) { const float inv = __builtin_amdgcn_exp2f(-(float)(i4 + e) * 0.41524101186092029f), an = pos * inv, c = __cosf(an), sn = __sinf(an);
      const float y1 = x1[e] * c - x2[e] * sn, y2 = x2[e] * c + x1[e] * sn; x1[e] = y1; x2[e] = y2; }
  }
  u32x2 oa, ob; oa.x = pk2(x1[0], x1[1]); oa.y = pk2(x1[2], x1[3]); ob.x = pk2(x2[0], x2[1]); ob.y = pk2(x2[2], x2[3]);
  *(u32x2*)(KC + kvo + d1) = oa; *(u32x2*)(KC + kvo + d1 + 32) = ob;
}
__device__ __forceinline__ void kv_ctx_from_part(const float* __restrict__ part, bf16_t* __restrict__ KC, bf16_t* __restrict__ VC, int row, const float* __restrict__ kg, int lane) {
  const int r = row - MLAT, head = lane >> 4, s = lane & 15, half = s >> 3, i4 = (s & 7) * 4, d1 = half * 64 + i4;
  const float* pk = part + (size_t)r * 1024 + head * 128 + d1; const float* pv = part + (size_t)r * 1024 + 512 + lane * 8;
  f32x4 x1 = {0.f, 0.f, 0.f, 0.f}, x2 = x1, v0 = x1, v1 = x1;
#pragma unroll
  for (int ks = 0; ks < 8; ++ks) { const size_t o = (size_t)ks * 1024 * 1024; x1 += *(const f32x4*)(pk + o); x2 += *(const f32x4*)(pk + o + 32); v0 += *(const f32x4*)(pv + o); v1 += *(const f32x4*)(pv + o + 4); }
  float ss = (x1.x * x1.x + x1.y * x1.y) + (x1.z * x1.z + x1.w * x1.w) + (x2.x * x2.x + x2.y * x2.y) + (x2.z * x2.z + x2.w * x2.w);
  ss += __shfl_xor(ss, 1); ss += __shfl_xor(ss, 2); ss += __shfl_xor(ss, 4); ss += __shfl_xor(ss, 8);
  const float rstd = 1.0f / sqrtf(ss * (1.0f / 128.0f) + EPS);
  x1 = x1 * rstd * *(const f32x4*)(kg + d1); x2 = x2 * rstd * *(const f32x4*)(kg + d1 + 32);
  const size_t kvo = ((size_t)((r >> 8) * 4 + head) * 4352 + (r & (CTXL - 1))) * 128;
  u32x2 oa, ob; oa.x = pk2(x1.x, x1.y); oa.y = pk2(x1.z, x1.w); ob.x = pk2(x2.x, x2.y); ob.y = pk2(x2.z, x2.w);
  *(u32x2*)(KC + kvo + d1) = oa; *(u32x2*)(KC + kvo + d1 + 32) = ob;
  u32x4 w; w.x = pk2(v0.x, v0.y); w.y = pk2(v0.z, v0.w); w.z = pk2(v1.x, v1.y); w.w = pk2(v1.z, v1.w);
  *(u32x4*)(VC + kvo + (lane & 15) * 8) = w;
}
__device__ __forceinline__ void bf8_to_f(const u32x4 w, float* f) {
  f[0] = __uint_as_float(w.x << 16); f[1] = __uint_as_float(w.x & 0xffff0000u); f[2] = __uint_as_float(w.y << 16); f[3] = __uint_as_float(w.y & 0xffff0000u);
  f[4] = __uint_as_float(w.z << 16); f[5] = __uint_as_float(w.z & 0xffff0000u); f[6] = __uint_as_float(w.w << 16); f[7] = __uint_as_float(w.w & 0xffff0000u);
}
__device__ __forceinline__ void conv_row(const bf16_t* __restrict__ P, bf16_t* __restrict__ CAT, int row, const float* __restrict__ cw, int lane) {
  int t, L; if (row < MLAT) { t = row & (SEQ - 1); L = SEQ; } else { t = (row - MLAT) & (CTXL - 1); L = CTXL; }
  const int c8 = lane * 8; const bf16_t* p = P + (size_t)row * LDP0 + c8;
  float gb[8], acc[8];
  bf8_to_f(*(const u32x4*)(p + 2560), gb);
#pragma unroll
  for (int e = 0; e < 8; ++e) acc[e] = 0.f;
#pragma unroll
  for (int j = 0; j < 3; ++j) { const int tt = t + j - 1; if (tt >= 0 && tt < L) { const bf16_t* q = p + (ptrdiff_t)(j - 1) * LDP0; float gc[8], u[8]; bf8_to_f(*(const u32x4*)(q + 3072), gc); bf8_to_f(*(const u32x4*)(q + 3584), u);
      const f32x4 w0 = *(const f32x4*)(cw + j * 512 + c8), w1 = *(const f32x4*)(cw + j * 512 + c8 + 4);
#pragma unroll
      for (int e = 0; e < 4; ++e) { acc[e] += w0[e] * (gc[e] * u[e]); acc[4 + e] += w1[e] * (gc[4 + e] * u[4 + e]); } } }
  u32x4 w; w.x = pk2(gb[0] * acc[0], gb[1] * acc[1]); w.y = pk2(gb[2] * acc[2], gb[3] * acc[3]); w.z = pk2(gb[4] * acc[4], gb[5] * acc[5]); w.w = pk2(gb[6] * acc[6], gb[7] * acc[7]);
  *(u32x4*)(CAT + (size_t)row * DM + 1536 + c8) = w;
}
__device__ __forceinline__ void pool_row(const bf16_t* __restrict__ P, bf16_t* __restrict__ CAT, int row, int lane) {
  const int t = row & (SEQ - 1), c8 = lane * 8, hw = 1 << (lane >> 4);
  const int lo = max(t - hw, 0), hi = min(t + hw, SEQ);
  const bf16_t* p = P + (size_t)row * LDP1 + 2560 + c8;
  float acc[8], f[8];
#pragma unroll
  for (int e = 0; e < 8; ++e) acc[e] = 0.f;
  for (int j = -8; j < 8; ++j) { const int tt = t + j; if (tt >= lo && tt < hi) { bf8_to_f(*(const u32x4*)(p + (ptrdiff_t)j * LDP1), f);
#pragma unroll
      for (int e = 0; e < 8; ++e) acc[e] += f[e]; } }
  bf8_to_f(*(const u32x4*)p, f);
  const float rn = 1.0f / (float)(hi - lo);
  u32x4 w; w.x = pk2(acc[0] * rn - f[0], acc[1] * rn - f[1]); w.y = pk2(acc[2] * rn - f[2], acc[3] * rn - f[3]); w.z = pk2(acc[4] * rn - f[4], acc[5] * rn - f[5]); w.w = pk2(acc[6] * rn - f[6], acc[7] * rn - f[7]);
  *(u32x4*)(CAT + (size_t)row * DM + 1536 + c8) = w;
}


template <int ROWS = 64>
__device__ __forceinline__ void mod_item(const float* __restrict__ Wm, const float* __restrict__ bm, const float* __restrict__ cc, const float* __restrict__ cctx, float* __restrict__ MODl, int item, unsigned char* lds) {
  int tid = threadIdx.x; asm volatile("" : "+v"(tid));
  const int lane = tid & 63, wave = __builtin_amdgcn_readfirstlane(tid >> 6), kc = item & (2048 / ROWS - 1), cb = item / (2048 / ROWS), k0 = kc * ROWS, col = cb * 2048 + wave * 256 + lane * 4;
  float* S = (float*)lds;
  if (tid < 5 * ROWS) { const int r = tid / ROWS, k = k0 + (tid % ROWS); S[tid] = silu(r < 4 ? cc[r * 2048 + k] : cctx[k]); }
  __syncthreads();
  f32x4 acc[5];
#pragma unroll
  for (int r = 0; r < 5; ++r) acc[r] = (f32x4){0.f, 0.f, 0.f, 0.f};
  const float* wp = Wm + (size_t)k0 * NMOD + col;
#pragma unroll 1
  for (int k = 0; k < ROWS; k += 16) { f32x4 w[16];
#pragma unroll
    for (int i = 0; i < 16; ++i) w[i] = __builtin_nontemporal_load((const f32x4*)(wp + (size_t)(k + i) * NMOD));
#pragma unroll
    for (int i = 0; i < 16; ++i)
#pragma unroll
      for (int r = 0; r < 5; ++r) acc[r] += S[r * ROWS + k + i] * w[i]; }
  f32x4 bias = {0.f, 0.f, 0.f, 0.f}; if (kc == 0) bias = *(const f32x4*)(bm + col);
#pragma unroll
  for (int r = 0; r < 5; ++r)
#pragma unroll
    for (int e = 0; e < 4; ++e) __hip_atomic_fetch_add(MODl + (size_t)r * NMOD + col + e, acc[r][e] + bias[e], __ATOMIC_RELAXED, __HIP_MEMORY_SCOPE_AGENT);
  __syncthreads();
}
__device__ __forceinline__ void fold_item(const float* __restrict__ wout, const float* __restrict__ pscale, const float* __restrict__ poolw, bf16_t* __restrict__ W1OUT, int it, unsigned char* lds) {
  int tid = threadIdx.x; asm volatile("" : "+v"(tid));
  const int lane = tid & 63, wave = __builtin_amdgcn_readfirstlane(tid >> 6), g = it >> 5, n0 = (it & 31) * 64;
  float* Ws = (float*)lds;
  for (int i = tid; i < 8192; i += NTHR) { const int d = i >> 6, nn = i & 63; Ws[i] = wout[(size_t)(1536 + g * 128 + d) * DM + n0 + nn] * pscale[g * 128 + d]; }
  __syncthreads();
  float acc[16];
#pragma unroll
  for (int i = 0; i < 16; ++i) acc[i] = 0.f;
  float* PW = (float*)(lds + 32768) + wave * 2048;
  { const float* pw = poolw + (size_t)(g * 128 + wave * 16) * 128;
#pragma unroll 8
    for (int j = 0; j < 32; ++j) PW[lane + 64 * j] = pw[lane + 64 * j]; }
  asm volatile("s_waitcnt vmcnt(0) lgkmcnt(0)" ::: "memory");
  for (int d = 0; d < 128; d += 4) { const float w0 = Ws[d * 64 + lane], w1 = Ws[(d + 1) * 64 + lane], w2 = Ws[(d + 2) * 64 + lane], w3 = Ws[(d + 3) * 64 + lane];
#pragma unroll
    for (int i = 0; i < 16; ++i) { const f32x4 p = *(const f32x4*)(PW + i * 128 + d); acc[i] += (p.x * w0 + p.y * w1) + (p.z * w2 + p.w * w3); } }
  bf16_t* dst = W1OUT + (size_t)(n0 + lane) * DM + 1536 + g * 128 + wave * 16;
  u32x4 w0, w1; w0.x = pk2(acc[0], acc[1]); w0.y = pk2(acc[2], acc[3]); w0.z = pk2(acc[4], acc[5]); w0.w = pk2(acc[6], acc[7]);
  w1.x = pk2(acc[8], acc[9]); w1.y = pk2(acc[10], acc[11]); w1.z = pk2(acc[12], acc[13]); w1.w = pk2(acc[14], acc[15]);
  *(u32x4*)dst = w0; *(u32x4*)(dst + 8) = w1;
  __syncthreads();
}

__device__ __forceinline__ void attn_decode(int i, int c, int& b, int& h, int& qb) {
  const int x = c & 7, j = i * 32 + (c >> 3), pair = 2 * x + j / 48, idx = j % 48;
  b = pair >> 2; h = (pair & 3) * 3 + idx / 16; qb = idx & 15;
}

template <class T> __device__ __forceinline__ T* gptr(T* p) { __attribute__((address_space(1))) T* g = (__attribute__((address_space(1))) T*)p; asm volatile("" : "+s"(g)); return (T*)g; }
__device__ __forceinline__ unsigned char* lw(unsigned char* p) { return gptr(p); }
#define MOD   ((float*)(lw(ws) + WS_MOD))
#define W0IN  ((bf16_t*)(lw(ws) + WS_W0IN))
#define W0OUT ((bf16_t*)(lw(ws) + WS_W0OUT))
#define W0GU  ((bf16_t*)(lw(ws) + WS_W0GU))
#define W0DN  ((bf16_t*)(lw(ws) + WS_W0DN))
#define W1IN  ((bf16_t*)(lw(ws) + WS_W1IN))
#define W1OUT ((bf16_t*)(lw(ws) + WS_W1OUT))
#define W1GU  ((bf16_t*)(lw(ws) + WS_W1GU))
#define W1DN  ((bf16_t*)(lw(ws) + WS_W1DN))
#define XN    ((bf16_t*)(lw(ws) + WS_XN))
#define H     ((bf16_t*)(lw(ws) + WS_H))
#define PROJ  ((bf16_t*)(lw(ws) + WS_PROJ))
#define CAT   ((bf16_t*)(lw(ws) + WS_CAT))
#define HID   ((bf16_t*)(lw(ws) + WS_HID))
#define PP    ((float*)(lw(ws) + WS_PP))
#define KCB   ((bf16_t*)(lw(ws) + WS_KC))
#define VCB   ((bf16_t*)(lw(ws) + WS_VC))
#define SSXI(k) ((float*)(lw(ws) + WS_SSX) + (size_t)(k) * 68 * 256 * 8)
#define CNTI(k) ((unsigned*)(lw(ws) + WS_CNT) + (k) * 68 * 64)
#ifndef ONLY_PHASE
#define ONLY_PHASE -1
#endif
#define PH(k) (ONLY_PHASE < 0 || ONLY_PHASE == (k))
#define A (*Ap)
#define GRID_BAR() xcd_barrier(bar)
template <int layer, bool FIXED>
__device__ __forceinline__ void attn_units(const __attribute__((address_space(4))) Args* Ap, unsigned char* ws, unsigned char* lds, const int c, const int nunits, const float sbound) {
      for (int i = 0; ; ++i) {
        const int L = i * 256 + c; if (L >= nunits || i >= 4) break;
        att::UnitArgs u;
        if (L < 768) { int b, h, qb; attn_decode(i, c, b, h, qb);
          u.qrow0 = b * SEQ + qb * 256; u.qcol = h * 128; u.kvbase = (b * 4 + h / 3) * 4352 * 128;
          u.tpos0 = qb * 256; u.rope = 1; u.ocol = h * 128; u.nB = -sbound;
          if (layer == 0) { u.kstart = 0; u.NT = 68; u.sinkl2 = 0.f; u.has_sink = 0; }
          else { u.kstart = qb * 256 - 128; u.NT = 12; u.sinkl2 = gptr(A.l1_sink)[h] * 1.4426950408889634f; u.has_sink = 1; }
        } else { const int j = L - 768, b = j / 12, h = j % 12;
          u.qrow0 = MLAT + b * CTXL; u.qcol = h * 128; u.kvbase = (b * 4 + h / 3) * 4352 * 128;
          u.tpos0 = 0; u.rope = 0; u.ocol = h * 128; u.kstart = 0; u.NT = 4; u.sinkl2 = 0.f; u.has_sink = 0; u.nB = -sbound; }
        if constexpr (layer == 0) att::attn_unit<LDP0, false, FIXED>(PROJ, KCB, VCB, CAT, gptr(A.l0_q_g), u, (char*)lds);
        else att::attn_unit<LDP1, true, FIXED>(PROJ, KCB, VCB, CAT, gptr(A.l1_q_g), u, (char*)lds);
        __syncthreads();
      }
}
template <int layer>
__device__ __forceinline__ void layer_fwd(const __attribute__((address_space(4))) Args* Ap, unsigned char* ws, unsigned char* lds, const XcdBarrier bar, const int G, const int c) {
  int tid_ = threadIdx.x; asm volatile("" : "+v"(tid_));
  const int tid = tid_, lane = tid & 63, wave = __builtin_amdgcn_readfirstlane(tid >> 6), gw = c * NWAVES + wave, ngw = G * NWAVES; (void)tid;
  PG8_LAS unsigned char* ldsl = (PG8_LAS unsigned char*)lds;
    const float* mod = MOD + (size_t)layer * 5 * NMOD;
    const int Mrows = layer == 0 ? MALL : MLAT;
    if constexpr (layer == 0) {
      if (PH(3)) norm_mod_rows<false, false>(gptr(A.x), gptr(A.ctx), MALL, gptr(A.l0_norm1_g), mod, 0, 2048, XN, gw, ngw, lane);
      GRID_BAR();
    }
    if (PH(4)) {
      if constexpr (layer == 1) {
        norm_mod_rows<true, true>(H, H + (size_t)MLAT * DM, MALL, gptr(A.l1_norm1_g), mod, 0, 2048, XN, gw, ngw, lane, PP, MOD + 4 * NMOD + 5 * 2048, MLAT);
        if (gw < MCTX) { __builtin_amdgcn_fence(__ATOMIC_RELEASE, "agent"); asm volatile("s_waitcnt vmcnt(0)" ::: "memory");
          if (lane == 0) __hip_atomic_fetch_add((unsigned*)(lw(ws) + WS_CNTX), 1u, __ATOMIC_RELAXED, __HIP_MEMORY_SCOPE_AGENT); }
      }
      pg8::Gemm g{XN, layer == 0 ? W0IN : W1IN, layer == 0 ? MALL : MLAT, layer == 0 ? LDP0 : LDP1, DM, DM}; pg8::StaticOrder S; S.init(g.M, g.N, G, c);
      pg8::EpiStoreBf16 E{PROJ, g.N, VCB};
      pg8::gemm_phase<pg8::EpiStoreBf16, pg8::StaticOrder, false, true>(ldsl, g, S, E);
      if (layer == 1) {
        if (c < 128) {
          if (threadIdx.x == 0) { unsigned sp = 0; unsigned* cx = (unsigned*)(lw(ws) + WS_CNTX);
            while (__hip_atomic_load(cx, __ATOMIC_RELAXED, __HIP_MEMORY_SCOPE_AGENT) < (unsigned)MCTX) { __builtin_amdgcn_s_sleep(2); if (++sp > (1u << 22)) break; }
            __builtin_amdgcn_fence(__ATOMIC_ACQUIRE, "agent"); asm volatile("s_waitcnt vmcnt(0)" ::: "memory"); }
          __syncthreads();
          pg8::Gemm g2{XN, W1IN, MALL, LDP1, 256, DM}; pg8::CtxSplitOrder S2{8, 4, 6, 128, G, c}; pg8::EpiPartF32 E2{PP, 1024, 1536};
          pg8::gemm_phase<pg8::EpiPartF32, pg8::CtxSplitOrder, true, true>(ldsl, g2, S2, E2); } }
      if (layer == 0 && c >= 64) {
        constexpr int I_IN1 = 32 * 48, I_OUT1 = 24 * 32, I_GU = 32 * 88, I_DN = 88 * 32; int ln = lane; asm volatile("" : "+v"(ln));
        for (int it = (c - 64) * NWAVES + wave; it < I_IN1 + I_OUT1 + 2 * I_GU; it += 192 * NWAVES) { int r = it;
          if (r < I_IN1) { tr_item<0>(gptr(A.l1_w_in), 3072, W1IN, DM, r, ln); continue; } r -= I_IN1;
          if (r < I_OUT1) { tr_item<0>(gptr(A.l1_w_out), DM, W1OUT, DM, r, ln); continue; } r -= I_OUT1;
          if (r < I_GU) { tr_item<1>(gptr(A.l1_w_gate), FFN, W1GU, DM, r, ln); continue; } r -= I_GU;
          tr_item<2>(gptr(A.l1_w_up), FFN, W1GU, DM, r, ln); } }
    }
    GRID_BAR();
    if (PH(5)) { int ln = lane; asm volatile("" : "+v"(ln)); if (layer == 0) { for (int row = gw; row < MALL; row += ngw) { knorm_row<LDP0>(PROJ, KCB, VCB, row, gptr(A.l0_k_g), ln); conv_row(PROJ, CAT, row, gptr(A.l0_conv_w), ln); } }
    else            { for (int row = gw; row < MALL; row += ngw) { if (row < MLAT) { knorm_row<LDP1>(PROJ, KCB, VCB, row, gptr(A.l1_k_g), ln); pool_row(PROJ, CAT, row, ln); } else kv_ctx_from_part(PP, KCB, VCB, row, gptr(A.l1_k_g), ln); } } }
    GRID_BAR();
    if (PH(6)) {
      const int nunits = layer == 0 ? 816 : 768;
      float sbound; { const float* qgp = layer == 0 ? gptr(A.l0_q_g) : gptr(A.l1_q_g); const float* kgp = layer == 0 ? gptr(A.l0_k_g) : gptr(A.l1_k_g);
        float mq = fmaxf(fabsf(qgp[lane]), fabsf(qgp[lane + 64])), mk = fmaxf(fabsf(kgp[lane]), fabsf(kgp[lane + 64]));
#pragma unroll
        for (int o = 1; o < 64; o <<= 1) { mq = fmaxf(mq, __shfl_xor(mq, o)); mk = fmaxf(mk, __shfl_xor(mk, o)); }
        sbound = 128.0f * mq * mk * att::SCALE * 1.4426950408889634f * 1.02f; }
      const bool fixed_sm = __builtin_amdgcn_readfirstlane(sbound <= 60.0f ? 1 : 0) != 0;
      if (fixed_sm) attn_units<layer, true>(Ap, ws, lds, c, nunits, sbound); else attn_units<layer, false>(Ap, ws, lds, c, nunits, sbound);
      if (layer == 0 && c >= 48) {
        const int idx = c - 48;
        if (idx < 128) mod_item(gptr(A.l0_w_mod), gptr(A.l0_b_mod), gptr(A.c), gptr(A.c_ctx), MOD, 64 + idx, lds);
        else { int ln = lane; asm volatile("" : "+v"(ln));
          for (int it = (idx - 128) * NWAVES + wave; it < 32 * 32; it += 80 * NWAVES) tr_item<0>(gptr(A.l0_w_out), DM, W0OUT, DM, it, ln); } }
    }
    GRID_BAR();
    if (PH(7)) {
      pg8::Gemm g{CAT, layer == 0 ? W0OUT : W1OUT, Mrows, DM, DM, DM}; pg8::PanelOrder S{Mrows / 256, G, c};
      if constexpr (layer == 0) { pg8::EpiResNorm<false, 0> E{gptr(A.x), gptr(A.ctx) - (size_t)MLAT * DM, mod + 2 * 2048, H, XN, nullptr, gptr(A.l0_norm2_g), mod + 4 * 2048, mod + 3 * 2048, SSXI(0), CNTI(0), ldsl + 131072 + 2048};
        pg8::gemm_phase<pg8::EpiResNorm<false, 0>, pg8::PanelOrder, true, true>(ldsl, g, S, E); }
      else { pg8::EpiResNorm<true, 0> E{H, H, mod + 2 * 2048, H, XN, nullptr, gptr(A.l1_norm2_g), mod + 4 * 2048, mod + 3 * 2048, SSXI(2), CNTI(2), ldsl + 131072 + 2048};
        pg8::gemm_phase<pg8::EpiResNorm<true, 0>, pg8::PanelOrder, true, true>(ldsl, g, S, E); }
      if (layer == 0 && !(c < 64 && (c & 7) < 4)) {
        const int idx = c >= 64 ? 32 + (c - 64) : (c >> 3) * 4 + ((c & 7) - 4);
        constexpr int I_GU = 32 * 88, I_DN = 88 * 32; int ln = lane; asm volatile("" : "+v"(ln));
        for (int it = idx * NWAVES + wave; it < 2 * I_GU + I_DN; it += 224 * NWAVES) { int r = it;
          if (r < I_GU) { tr_item<1>(gptr(A.l0_w_gate), FFN, W0GU, DM, r, ln); continue; } r -= I_GU;
          if (r < I_GU) { tr_item<2>(gptr(A.l0_w_up), FFN, W0GU, DM, r, ln); continue; } r -= I_GU;
          tr_item<0>(gptr(A.l0_w_down), DM, W0DN, FFN, r, ln); } }
    }
    GRID_BAR();
    if (PH(9)) {
      pg8::Gemm g{XN, layer == 0 ? W0GU : W1GU, Mrows, 2 * FFN, DM, DM}; pg8::StaticOrder S; S.init(g.M, g.N, G, c);
      pg8::EpiSwiGLU E{HID, FFN};
      pg8::gemm_phase<pg8::EpiSwiGLU, pg8::StaticOrder, false, true>(ldsl, g, S, E);
      if (layer == 0 && c >= 176) {
        for (int it = c - 176; it < 192; it += 80) mod_item(gptr(A.l1_w_mod), gptr(A.l1_b_mod), gptr(A.c), gptr(A.c_ctx), MOD + (size_t)5 * NMOD, it, lds); }
    }
    GRID_BAR();
    if (PH(10)) {
      pg8::Gemm g{HID, layer == 0 ? W0DN : W1DN, MLAT, DM, FFN, FFN}; pg8::PanelOrder S{MLAT / 256, G, c};
      if constexpr (layer == 0) { const float* mod1 = MOD + (size_t)5 * NMOD;
        pg8::EpiResNorm<true, 0> E{H, H, mod + 5 * 2048, H, XN, nullptr, gptr(A.l1_norm1_g), mod1 + 2048, mod1, SSXI(1), CNTI(1), ldsl + 131072 + 2048};
        pg8::gemm_phase<pg8::EpiResNorm<true, 0>, pg8::PanelOrder, true, true>(ldsl, g, S, E); }
      else { pg8::EpiResNorm<true, 1> E{H, H, mod + 5 * 2048, nullptr, nullptr, gptr(A.out), gptr(A.final_g), nullptr, nullptr, SSXI(3), CNTI(3), ldsl + 131072 + 2048};
        pg8::gemm_phase<pg8::EpiResNorm<true, 1>, pg8::PanelOrder, true, true>(ldsl, g, S, E); }
      if (layer == 0) {
        if (c < 128) { pg8::Gemm g2{HID, W0DN, MALL, DM, 1408, FFN}; pg8::CtxSplitOrder S2{4, 8, 0, 128, G, c}; pg8::EpiPartF32 E2{PP, 2048, 0};
          pg8::gemm_phase<pg8::EpiPartF32, pg8::CtxSplitOrder, true, true>(ldsl, g2, S2, E2);
 }
        else { const int idx = c - 128; fold_item(gptr(A.l1_w_out), gptr(A.l1_pool_scale), gptr(A.l1_pool_w), W1OUT, idx, lds); int ln = lane; asm volatile("" : "+v"(ln));
          for (int it = idx * NWAVES + wave; it < 88 * 32; it += 128 * NWAVES) tr_item<0>(gptr(A.l1_w_down), DM, W1DN, FFN, it, ln); }
      }
    }
    if (layer == 0) GRID_BAR();
}
__global__ void __launch_bounds__(NTHR, 2) fwd_mega(Args Araw) {
  const __attribute__((address_space(4))) Args* Ap = (const __attribute__((address_space(4))) Args*)__builtin_amdgcn_kernarg_segment_ptr();
  asm volatile("" : "+s"(Ap));
  extern __shared__ __attribute__((aligned(16))) unsigned char lds[];
  cg::grid_group grid = cg::this_grid();
  const int tid = threadIdx.x, lane = tid & 63, wave = __builtin_amdgcn_readfirstlane(tid >> 6);
  const int G = gridDim.x, c = blockIdx.x, gw = c * NWAVES + wave, ngw = G * NWAVES;
  unsigned char* ws = gptr(A.ws);
  PG8_LAS unsigned char* ldsl = (PG8_LAS unsigned char*)lds;
  volatile LAS unsigned* bst = (volatile LAS unsigned*)((LAS unsigned char*)lds + 131072 + 1024);
  if (tid < 64) ((LAS unsigned*)((LAS unsigned char*)lds + 131072 + 1024))[tid] = 0u;
  __syncthreads();
  XcdBarrier bar = xcd_barrier_post((unsigned*)(ws + WS_BAR), bst);

  if (PH(0)) {
    if (c < 128) mod_item<32>(gptr(A.l0_w_mod), gptr(A.l0_b_mod), gptr(A.c), gptr(A.c_ctx), MOD, c, lds);
    else { int ln = lane; asm volatile("" : "+v"(ln));
      for (int it = (c - 128) * NWAVES + wave; it < 32 * 64; it += 128 * NWAVES) tr_item<0>(gptr(A.l0_w_in), 4096, W0IN, DM, it, ln); }
  }
  GRID_BAR();
  if (gridDim.x == 0x7fffffu) grid.sync();

  layer_fwd<0>(Ap, ws, lds, bar, G, c);
  layer_fwd<1>(Ap, ws, lds, bar, G, c);
#undef A
}
#undef MOD
#undef W0IN
#undef W0OUT
#undef W0GU
#undef W0DN
#undef W1IN
#undef W1OUT
#undef W1GU
#undef W1DN
#undef XN
#undef H
#undef PROJ
#undef CAT
#undef HID
#undef PP
#undef KCB
#undef VCB
#undef SSXI
#undef CNTI


extern "C" void kernel_launch(void* const* d_in, const int* in_sizes, int n_in, void* d_out, int out_size, void* d_ws, size_t ws_size, hipStream_t stream) {
  static int grid_blocks = 0;
  if (grid_blocks == 0) {
    if (n_in != 31 || in_sizes[0] != MLAT * DM || out_size != MLAT * DM || ws_size < WS_END) {
      fprintf(stderr, "kernel_launch: unexpected problem: n_in %d in0 %d out %d ws %zu (need %zu)\n", n_in, n_in > 0 ? in_sizes[0] : -1, out_size, ws_size, (size_t)WS_END); grid_blocks = -1; return; }
    int dev = 0, cus = 0, per_cu = 0;
    hipGetDevice(&dev); hipDeviceGetAttribute(&cus, hipDeviceAttributeMultiprocessorCount, dev);
    if (hipFuncSetAttribute((const void*)fwd_mega, hipFuncAttributeMaxDynamicSharedMemorySize, LDS_BYTES) != hipSuccess) { fprintf(stderr, "kernel_launch: hipFuncSetAttribute failed\n"); grid_blocks = -1; return; }
    hipOccupancyMaxActiveBlocksPerMultiprocessor(&per_cu, (const void*)fwd_mega, NTHR, LDS_BYTES);
    (void)hipGetLastError();
    if (per_cu < 1) per_cu = 1;
    grid_blocks = cus;
    if (grid_blocks != 256) fprintf(stderr, "kernel_launch: note: %d CUs (kernel assumes a 256-workgroup grid for its static work split)\n", grid_blocks);
    grid_blocks = 256;
  }
  if (grid_blocks < 0) return;
  if (hipMemsetAsync((char*)d_ws, 0, ZERO_BYTES, stream) != hipSuccess) { fprintf(stderr, "kernel_launch: memset failed\n"); return; }
  Args a{};
  const float** p = (const float**)&a;
  for (int i = 0; i < 31; ++i) p[i] = (const float*)d_in[i];
  a.out = (float*)d_out; a.ws = (unsigned char*)d_ws;
  void* args[] = {&a};
  hipError_t e = hipLaunchCooperativeKernel((const void*)fwd_mega, dim3(grid_blocks), dim3(NTHR), args, LDS_BYTES, stream);
  if (e != hipSuccess) fprintf(stderr, "kernel_launch: cooperative launch failed: %s\n", hipGetErrorString(e));
}
```

```cpp
#include <hip/hip_runtime.h>
#include <hip/hip_cooperative_groups.h>
#include <cstdio>
#include <cstdint>
#include <cstddef>
namespace pg8 {
#define PG8_LAS __attribute__((address_space(3)))
typedef unsigned short bf16_t;
typedef short bf16x8 __attribute__((ext_vector_type(8)));
typedef float f32x4 __attribute__((ext_vector_type(4)));
typedef unsigned u32x4 __attribute__((ext_vector_type(4)));
constexpr int BM = 256, BK = 64, HALF = 128, HTB = HALF * BK * 2  , STAGE_BYTES = 8 * HTB, NXCD = 8, WGM = 8;

__host__ __device__ __forceinline__ int lds_byte(int r, int c) { const int st = (r >> 4) * 2 + (c >> 5), rr = r & 15, cc = c & 31, ob = rr * 64 + cc * 2; return st * 1024 + (ob ^ (((ob >> 9) & 1) << 5)); }
__host__ __device__ __forceinline__ void stage_rc(int b, int& R, int& C) { const int st = b / 1024, sb = b % 1024, swz = sb ^ (((sb >> 9) & 1) << 5); R = (st >> 1) * 16 + swz / 64; C = (st & 1) * 32 + (swz % 64) / 2; }
__host__ __device__ __forceinline__ int perm32(int rho) { const int n = rho >> 4, i = rho & 15; return 8 * (i >> 2) + 4 * n + (i & 3); }

struct Unit { int pm, pn, ks; };
struct Gemm { const bf16_t* A; const bf16_t* Bt; int M, N, K, ld; };

struct StaticOrder {
    int nM, nN, nwg, G, c;
    __host__ __device__ void init(int M, int N, int G_, int c_) { nM = M / BM; nN = N / BM; nwg = nM * nN; G = G_; c = c_; }
    __host__ __device__ bool next(int i, Unit& u) const {
        const long L = (long)i * G + c; if (L >= nwg) return false;
        int wgid = (int)L; { const int q = nwg / NXCD, r = nwg % NXCD, xcd = wgid % NXCD, off = wgid / NXCD; wgid = (xcd < r ? xcd * (q + 1) : r * (q + 1) + (xcd - r) * q) + off; }
        const int nig = WGM * nN, gid = wgid / nig, fm = gid * WGM, gsz = (nM - fm) < WGM ? (nM - fm) : WGM;
        u.pm = fm + ((wgid % nig) % gsz); u.pn = (wgid % nig) / gsz; u.ks = 0; return true;
    }
    __device__ __forceinline__ void a_ready(const Unit&) const {}
    __device__ __forceinline__ void done(const Unit&) const {}
};

__device__ __forceinline__ unsigned cvt_pk_bf16(float lo, float hi) { unsigned r; asm volatile("v_cvt_pk_bf16_f32 %0, %1, %2" : "=v"(r) : "v"(lo), "v"(hi)); return r; }
typedef float f32x2 __attribute__((ext_vector_type(2)));
struct EpiStoreBf16 {
    static constexpr bool PERM = true, AFTER_DRAIN = false;
    bf16_t* O; int ldc; bf16_t* VC;
    __device__ __forceinline__ void operator()(const f32x4 (&acc)[2][2][4][2], const Unit& u, int wr, int wc, int fr, int fq) const {
        const int row0 = u.pm * BM + wr * 64 + fr; const int col0 = u.pn * BM + wc * 32 + 8 * fq;
        const bool isv = (u.pn == 8 || u.pn == 9);
#pragma unroll
        for (int ai = 0; ai < 2; ++ai)
#pragma unroll
            for (int m = 0; m < 4; ++m) { const int row = row0 + ai * HALF + m * 16; bf16_t* rowp = O + (size_t)row * ldc + col0;
                if (isv) { const int b = row < 16384 ? (row >> 12) : ((row - 16384) >> 8), pos = row < 16384 ? 256 + (row & 4095) : ((row - 16384) & 255);
                    rowp = VC + ((size_t)(b * 4 + 2 * (u.pn - 8)) * 4352 + pos) * 128 + wc * 32 + 8 * fq; }
#pragma unroll
                for (int bj = 0; bj < 2; ++bj) { const f32x4 v0 = acc[ai][bj][m][0], v1 = acc[ai][bj][m][1];
                    u32x4 w; w.x = cvt_pk_bf16(v0[0], v0[1]); w.y = cvt_pk_bf16(v0[2], v0[3]); w.z = cvt_pk_bf16(v1[0], v1[1]); w.w = cvt_pk_bf16(v1[2], v1[3]);
                    *(u32x4*)(rowp + (isv ? (size_t)bj * 4352 * 128 : (size_t)bj * HALF)) = w; } }
    }
};
__device__ __forceinline__ float silu_f(float x) { return x * __builtin_amdgcn_rcpf(1.0f + __builtin_amdgcn_exp2f(-1.4426950408889634f * x)); }
struct EpiSwiGLU {
    static constexpr bool PERM = true, AFTER_DRAIN = false;
    bf16_t* O; int ldc;
    __device__ __forceinline__ void operator()(const f32x4 (&acc)[2][2][4][2], const Unit& u, int wr, int wc, int fr, int fq) const {
        const int row0 = u.pm * BM + wr * 64 + fr; const int col0 = u.pn * HALF + wc * 32 + 8 * fq;
#pragma unroll
        for (int ai = 0; ai < 2; ++ai)
#pragma unroll
            for (int m = 0; m < 4; ++m) { bf16_t* rowp = O + (size_t)(row0 + ai * HALF + m * 16) * ldc + col0;
                const f32x4 g0 = acc[ai][0][m][0], g1 = acc[ai][0][m][1], u0 = acc[ai][1][m][0], u1 = acc[ai][1][m][1];
                u32x4 w; w.x = cvt_pk_bf16(silu_f(g0[0]) * u0[0], silu_f(g0[1]) * u0[1]); w.y = cvt_pk_bf16(silu_f(g0[2]) * u0[2], silu_f(g0[3]) * u0[3]);
                w.z = cvt_pk_bf16(silu_f(g1[0]) * u1[0], silu_f(g1[1]) * u1[1]); w.w = cvt_pk_bf16(silu_f(g1[2]) * u1[2], silu_f(g1[3]) * u1[3]);
                *(u32x4*)rowp = w; }
    }
};
template <bool BASE_BF16, bool OUT_BF16>
struct EpiResGate {
    static constexpr bool PERM = true, AFTER_DRAIN = false;
    const void* base_lat; const void* base_ctx; void* out; const float* gate;
    __device__ __forceinline__ void operator()(const f32x4 (&acc)[2][2][4][2], const Unit& u, int wr, int wc, int fr, int fq) const {
        const int col0 = u.pn * BM + wc * 32 + 8 * fq; const int modrow = u.pm < 64 ? (u.pm >> 4) : 4;
        const void* base = u.pm < 64 ? base_lat : base_ctx;
        f32x4 gv[2][2];
#pragma unroll
        for (int bj = 0; bj < 2; ++bj)
#pragma unroll
            for (int n = 0; n < 2; ++n) gv[bj][n] = *(const f32x4*)(gate + modrow * 12288 + col0 + bj * HALF + 4 * n);
#pragma unroll
        for (int ai = 0; ai < 2; ++ai)
#pragma unroll
            for (int m = 0; m < 4; ++m) { const size_t off = (size_t)(u.pm * BM + ai * HALF + wr * 64 + m * 16 + fr) * 2048 + col0;
#pragma unroll
                for (int bj = 0; bj < 2; ++bj) { f32x4 b0, b1;
                    if constexpr (BASE_BF16) { const u32x4 w = *(const u32x4*)((const bf16_t*)base + off + bj * HALF);
                        b0 = (f32x4){__uint_as_float(w.x << 16), __uint_as_float(w.x & 0xffff0000u), __uint_as_float(w.y << 16), __uint_as_float(w.y & 0xffff0000u)};
                        b1 = (f32x4){__uint_as_float(w.z << 16), __uint_as_float(w.z & 0xffff0000u), __uint_as_float(w.w << 16), __uint_as_float(w.w & 0xffff0000u)}; }
                    else { b0 = *(const f32x4*)((const float*)base + off + bj * HALF); b1 = *(const f32x4*)((const float*)base + off + bj * HALF + 4); }
                    const f32x4 o0 = b0 + gv[bj][0] * acc[ai][bj][m][0], o1 = b1 + gv[bj][1] * acc[ai][bj][m][1];
                    if constexpr (OUT_BF16) { u32x4 w; w.x = cvt_pk_bf16(o0[0], o0[1]); w.y = cvt_pk_bf16(o0[2], o0[3]); w.z = cvt_pk_bf16(o1[0], o1[1]); w.w = cvt_pk_bf16(o1[2], o1[3]);
                        *(u32x4*)((bf16_t*)out + off + bj * HALF) = w; }
                    else { *(f32x4*)((float*)out + off + bj * HALF) = o0; *(f32x4*)((float*)out + off + bj * HALF + 4) = o1; } } }
    }
};
struct EpiPartF32 {
    static constexpr bool PERM = false, AFTER_DRAIN = false;
    float* out; int ldp, col0;
    __device__ __forceinline__ void operator()(const f32x4 (&acc)[2][2][4][2], const Unit& u, int wr, int wc, int fr, int fq) const {
        const int colb = u.pn * BM + wc * 32 + 4 * fq - col0;
#pragma unroll
        for (int ai = 0; ai < 2; ++ai)
#pragma unroll
            for (int m = 0; m < 4; ++m) { const size_t off = ((size_t)u.ks * 1024 + (size_t)((u.pm - 64) * BM + ai * HALF + wr * 64 + m * 16 + fr)) * ldp + colb;
#pragma unroll
                for (int bj = 0; bj < 2; ++bj)
#pragma unroll
                    for (int n = 0; n < 2; ++n) *(f32x4*)(out + off + bj * HALF + n * 16) = acc[ai][bj][m][n]; }
    }
};
struct CtxSplitOrder {
    int nks, npn, pn0, nsub, G, c;
    __device__ bool next(int i, Unit& u) const { const int L = i * G + c; if (L >= nsub) return false; u.ks = L % nks; const int t = L / nks; u.pn = pn0 + t % npn; u.pm = 64 + t / npn; return true; }
    __device__ __forceinline__ void a_ready(const Unit&) const {}
    __device__ __forceinline__ void done(const Unit&) const {}
};

template <bool BASE_BF16, int MODE>
struct EpiResNorm {
    static constexpr bool PERM = true, AFTER_DRAIN = false;
    const void* base_lat; const void* base_ctx; const float* gate;
    bf16_t* Hout; bf16_t* XNout; float* Fout;
    const float* g; const float* sc; const float* sh;
    float* ssx; unsigned* cnt;
    PG8_LAS unsigned char* xl;
    __device__ __forceinline__ void operator()(f32x4 (&acc)[2][2][4][2], const Unit& u, int wr, int wc, int fr, int fq) const {
        const int tid = threadIdx.x, lane = tid & 63;
        const int col0 = u.pn * BM + wc * 32 + 8 * fq; const int modrow = u.pm < 64 ? (u.pm >> 4) : 4;
        const void* base = u.pm < 64 ? base_lat : base_ctx;
        PG8_LAS float* P = (PG8_LAS float*)xl; PG8_LAS float* S = (PG8_LAS float*)(xl + 4096);
#pragma unroll
        for (int bj = 0; bj < 2; ++bj) { const f32x4 g0 = *(const f32x4*)(gate + modrow * 12288 + col0 + bj * HALF), g1 = *(const f32x4*)(gate + modrow * 12288 + col0 + bj * HALF + 4);
#pragma unroll
            for (int ai = 0; ai < 2; ++ai)
#pragma unroll
                for (int m = 0; m < 4; ++m) { const size_t off = (size_t)(u.pm * BM + ai * HALF + wr * 64 + m * 16 + fr) * 2048 + col0 + bj * HALF; f32x4 b0, b1;
                    if constexpr (BASE_BF16) { const u32x4 w = __builtin_nontemporal_load((const u32x4*)((const bf16_t*)base + off));
                        b0 = (f32x4){__uint_as_float(w.x << 16), __uint_as_float(w.x & 0xffff0000u), __uint_as_float(w.y << 16), __uint_as_float(w.y & 0xffff0000u)};
                        b1 = (f32x4){__uint_as_float(w.z << 16), __uint_as_float(w.z & 0xffff0000u), __uint_as_float(w.w << 16), __uint_as_float(w.w & 0xffff0000u)}; }
                    else { b0 = __builtin_nontemporal_load((const f32x4*)((const float*)base + off)); b1 = __builtin_nontemporal_load((const f32x4*)((const float*)base + off + 4)); }
                    acc[ai][bj][m][0] = b0 + g0 * acc[ai][bj][m][0]; acc[ai][bj][m][1] = b1 + g1 * acc[ai][bj][m][1];
                    asm volatile("" : "+v"(acc[ai][bj][m][0]), "+v"(acc[ai][bj][m][1]));
                    if (m & 1) asm volatile("" ::: "memory"); } }
#pragma unroll
        for (int ai = 0; ai < 2; ++ai)
#pragma unroll
            for (int m = 0; m < 4; ++m) { float s = 0.f;
#pragma unroll
                for (int bj = 0; bj < 2; ++bj)
#pragma unroll
                    for (int n = 0; n < 2; ++n) { const f32x4 x = acc[ai][bj][m][n]; s += (x[0] * x[0] + x[1] * x[1]) + (x[2] * x[2] + x[3] * x[3]); }
                s += __shfl_xor(s, 16); s += __shfl_xor(s, 32);
                if (fq == 0) P[(ai * HALF + wr * 64 + m * 16 + fr) * 4 + wc] = s; }
        asm volatile("s_waitcnt lgkmcnt(0)" ::: "memory"); __builtin_amdgcn_s_barrier(); asm volatile("" ::: "memory");
        if (tid < 256) { const float tot = (P[tid * 4 + 0] + P[tid * 4 + 1]) + (P[tid * 4 + 2] + P[tid * 4 + 3]);
            __hip_atomic_store(ssx + ((size_t)u.pm * 256 + tid) * 8 + u.pn, tot, __ATOMIC_RELAXED, __HIP_MEMORY_SCOPE_AGENT); }
        asm volatile("s_waitcnt vmcnt(0)" ::: "memory");
        if (tid < 256 && lane == 0) __hip_atomic_fetch_add(cnt + 64 * u.pm, 1u, __ATOMIC_RELAXED, __HIP_MEMORY_SCOPE_AGENT);
        if constexpr (MODE == 0) {
#pragma unroll
            for (int bj = 0; bj < 2; ++bj)
#pragma unroll
                for (int ai = 0; ai < 2; ++ai)
#pragma unroll
                    for (int m = 0; m < 4; ++m) { const size_t off = (size_t)(u.pm * BM + ai * HALF + wr * 64 + m * 16 + fr) * 2048 + col0 + bj * HALF; const f32x4 h0 = acc[ai][bj][m][0], h1 = acc[ai][bj][m][1];
                        u32x4 w; w.x = cvt_pk_bf16(h0[0], h0[1]); w.y = cvt_pk_bf16(h0[2], h0[3]); w.z = cvt_pk_bf16(h1[0], h1[1]); w.w = cvt_pk_bf16(h1[2], h1[3]);
                        *(u32x4*)(Hout + off) = w; } }
        if (tid < 64) { unsigned sp = 0;
            while ((unsigned)__builtin_amdgcn_readfirstlane(__hip_atomic_load(cnt + 64 * u.pm, __ATOMIC_RELAXED, __HIP_MEMORY_SCOPE_AGENT)) < 32u) { __builtin_amdgcn_s_sleep(2); if (++sp > (1u << 22)) break; }
            __builtin_amdgcn_fence(__ATOMIC_ACQUIRE, "agent"); }
        asm volatile("s_waitcnt vmcnt(0) lgkmcnt(0)" ::: "memory"); __builtin_amdgcn_s_barrier(); asm volatile("" ::: "memory");
        if (tid < 256) { const float* slot = ssx + ((size_t)u.pm * 256 + tid) * 8; float q = 0.f;
#pragma unroll
            for (int t = 0; t < 8; ++t) q += __hip_atomic_load(slot + t, __ATOMIC_RELAXED, __HIP_MEMORY_SCOPE_AGENT);
            S[tid] = 1.0f / sqrtf(q * (1.0f / 2048.0f) + 1e-6f); }
        asm volatile("s_waitcnt vmcnt(0) lgkmcnt(0)" ::: "memory"); __builtin_amdgcn_s_barrier(); asm volatile("" ::: "memory");
#pragma unroll
        for (int bj = 0; bj < 2; ++bj) { const int cc = col0 + bj * HALF;
            f32x4 gs0 = *(const f32x4*)(g + cc), gs1 = *(const f32x4*)(g + cc + 4), sh0 = {0.f, 0.f, 0.f, 0.f}, sh1 = sh0;
            if constexpr (MODE == 0) { gs0 = gs0 * (1.0f + *(const f32x4*)(sc + modrow * 12288 + cc)); gs1 = gs1 * (1.0f + *(const f32x4*)(sc + modrow * 12288 + cc + 4));
                sh0 = *(const f32x4*)(sh + modrow * 12288 + cc); sh1 = *(const f32x4*)(sh + modrow * 12288 + cc + 4); }
#pragma unroll
            for (int ai = 0; ai < 2; ++ai)
#pragma unroll
                for (int m = 0; m < 4; ++m) { const int r = ai * HALF + wr * 64 + m * 16 + fr; const float rs = S[r]; const size_t off = (size_t)(u.pm * BM + r) * 2048 + cc;
                    const f32x4 h0 = acc[ai][bj][m][0], h1 = acc[ai][bj][m][1];
                    if constexpr (MODE == 0) {
                        const f32x4 y0 = h0 * rs * gs0 + sh0, y1 = h1 * rs * gs1 + sh1;
                        u32x4 x; x.x = cvt_pk_bf16(y0[0], y0[1]); x.y = cvt_pk_bf16(y0[2], y0[3]); x.z = cvt_pk_bf16(y1[0], y1[1]); x.w = cvt_pk_bf16(y1[2], y1[3]);
                        *(u32x4*)(XNout + off) = x; }
                    else { *(f32x4*)(Fout + off) = h0 * rs * gs0; *(f32x4*)(Fout + off + 4) = h1 * rs * gs1; }
                    if (m & 1) asm volatile("" ::: "memory"); } }
    }
};
struct PanelOrder {
    int nM, G, c;
    __device__ bool next(int i, Unit& u) const { const int x = c & 7, j = c >> 3; u.ks = 0;
        if (i < 2) { u.pm = i * 32 + 4 * x + (j >> 3); u.pn = j & 7; return u.pm < nM; }
        if (i == 2 && nM > 64 && c < 64 && x < 4) { u.pm = 64 + x; u.pn = j; return true; }
        return false; }
    __device__ __forceinline__ void a_ready(const Unit&) const {}
    __device__ __forceinline__ void done(const Unit&) const {}
};
template <class Epi, class Sched, bool ALIGN_EPI = false, bool SP2 = false>
__device__ __forceinline__ void gemm_phase(PG8_LAS unsigned char* lds, const Gemm g, const Sched& S, const Epi& E) {
    int tid_ = threadIdx.x; asm volatile("" : "+v"(tid_));
    const int tid = tid_, wid = __builtin_amdgcn_readfirstlane(tid >> 6), lane = tid & 63, wr = wid >> 2, wc = wid & 3, fr = lane & 15, fq = lane >> 4;
    const int K = g.ld, nt = g.K / BK;
    const size_t kslice = (size_t)g.K * 2;
    unsigned voffA[2], voffB[2];
#pragma unroll
    for (int i = 0; i < 2; ++i) { int R, C; stage_rc(tid * 16 + i * 8192, R, C); const int Rb = Epi::PERM ? ((R & ~31) + perm32(R & 31)) : R;
        voffA[i] = (unsigned)(R * K + C) * 2u; voffB[i] = (unsigned)(Rb * K + C) * 2u; }
    const size_t kstep = (size_t)(BK * 2);
    const size_t hstep = (size_t)HALF * K * 2;
    const size_t tstep = 2 * hstep;
    const unsigned ldsw = (unsigned)wid * 1024u;
    const int aoff = lds_byte(wr * 64 + fr, fq * 8), boff = lds_byte(wc * 32 + fr, fq * 8);
#define PG8_SA(b, h) (((b) * 2 + (h)) * HTB)
#define PG8_SB(b, h) ((4 + (b) * 2 + (h)) * HTB)
#define PG8_STAGE(bufoff, gbase, voff) do { _Pragma("unroll") for (int _i = 0; _i < 2; ++_i) \
        __builtin_amdgcn_global_load_lds((const unsigned*)((const char*)(gbase) + (voff)[_i]), (PG8_LAS unsigned*)(lds + (bufoff) + ldsw + _i * 8192), 16, 0, 0); } while (0)
#define PG8_LDA(dst, b, h) do { _Pragma("unroll") for (int m = 0; m < 4; ++m) _Pragma("unroll") for (int k = 0; k < 2; ++k) dst[m][k] = *(const PG8_LAS bf16x8*)(lds + PG8_SA(b, h) + aoff + m * 2048 + k * 1024); } while (0)
#define PG8_LDB(dst, b, h) do { _Pragma("unroll") for (int n = 0; n < 2; ++n) _Pragma("unroll") for (int k = 0; k < 2; ++k) dst[n][k] = *(const PG8_LAS bf16x8*)(lds + PG8_SB(b, h) + boff + n * 2048 + k * 1024); } while (0)
#define PG8_MMA(ai, bj, At, Bt) do { __builtin_amdgcn_s_setprio(1); _Pragma("unroll") for (int m = 0; m < 4; ++m) _Pragma("unroll") for (int n = 0; n < 2; ++n) _Pragma("unroll") for (int k = 0; k < 2; ++k) \
        acc[ai][bj][m][n] = __builtin_amdgcn_mfma_f32_16x16x32_bf16(Bt[n][k], At[m][k], acc[ai][bj][m][n], 0, 0, 0); __builtin_amdgcn_s_setprio(0); } while (0)
#define PG8_WAIT_V(n) asm volatile("s_waitcnt vmcnt(" #n ")" ::: "memory")
#define PG8_WAIT_L(n) asm volatile("s_waitcnt lgkmcnt(" #n ")" ::: "memory")
#define PG8_BAR __builtin_amdgcn_s_barrier()
#define PG8_SCHED __builtin_amdgcn_sched_barrier(0)
    Unit cur, nxt; int ui = 0;
    if (!S.next(0, cur)) return;
    f32x4 acc[2][2][4][2];
#pragma unroll
    for (int a = 0; a < 2; ++a)
#pragma unroll
        for (int b = 0; b < 2; ++b)
#pragma unroll
            for (int m = 0; m < 4; ++m)
#pragma unroll
                for (int n = 0; n < 2; ++n) acc[a][b][m][n] = (f32x4){0.f, 0.f, 0.f, 0.f};
    bf16x8 At[4][2], B0[2][2], B1[2][2];
    const char* cA = (const char*)g.A + (size_t)cur.pm * tstep + (size_t)cur.ks * kslice; const char* cB = (const char*)g.Bt + (size_t)cur.pn * tstep + (size_t)cur.ks * kslice;
    S.a_ready(cur);
    if constexpr (SP2) {
        PG8_STAGE(PG8_SB(0, 0), cB, voffB); PG8_STAGE(PG8_SB(0, 1), cB + hstep, voffB); PG8_STAGE(PG8_SA(0, 0), cA, voffA); PG8_STAGE(PG8_SA(0, 1), cA + hstep, voffA);
        if (wr == 1) PG8_BAR;
        PG8_WAIT_V(2); PG8_BAR;
        PG8_STAGE(PG8_SB(1, 0), cB + kstep, voffB); PG8_STAGE(PG8_SA(1, 0), cA + kstep, voffA); PG8_STAGE(PG8_SB(1, 1), cB + hstep + kstep, voffB);
        PG8_WAIT_V(6); PG8_BAR;
    } else {
        PG8_STAGE(PG8_SB(0, 0), cB, voffB); PG8_STAGE(PG8_SA(0, 0), cA, voffA); PG8_STAGE(PG8_SB(0, 1), cB + hstep, voffB); PG8_STAGE(PG8_SA(0, 1), cA + hstep, voffA);
        if (wr == 1) PG8_BAR;
        PG8_WAIT_V(4); PG8_BAR;
        PG8_STAGE(PG8_SB(1, 0), cB + kstep, voffB); PG8_STAGE(PG8_SA(1, 0), cA + kstep, voffA); PG8_STAGE(PG8_SB(1, 1), cB + hstep + kstep, voffB);
        PG8_WAIT_V(6); PG8_BAR;
    }
    for (;;) {
        const bool has_next = S.next(ui + 1, nxt);
        const char* nA = has_next ? (const char*)g.A + (size_t)nxt.pm * tstep + (size_t)nxt.ks * kslice : cA; const char* nB = has_next ? (const char*)g.Bt + (size_t)nxt.pn * tstep + (size_t)nxt.ks * kslice : cB;
        for (int t = 0; t < nt; t += 2) {
            const bool last = (t == nt - 2);
            const char* a1 = cA + (size_t)(t + 1) * kstep;
            const char* a2 = last ? nA : cA + (size_t)(t + 2) * kstep; const char* b2 = last ? nB : cB + (size_t)(t + 2) * kstep;
            const char* a3 = a2 + kstep; const char* b3 = b2 + kstep;
            if (last && has_next) S.a_ready(nxt);
            if constexpr (SP2) {
            PG8_LDB(B0, 0, 0); PG8_LDB(B1, 0, 1); PG8_SCHED; PG8_LDA(At, 0, 0); PG8_STAGE(PG8_SA(1, 1), a1 + hstep, voffA);
            PG8_WAIT_V(8); PG8_WAIT_L(0); PG8_BAR; PG8_MMA(0, 0, At, B0); PG8_MMA(0, 1, At, B1); PG8_BAR; PG8_SCHED;
            PG8_LDA(At, 0, 1); PG8_STAGE(PG8_SB(0, 0), b2, voffB); PG8_STAGE(PG8_SB(0, 1), b2 + hstep, voffB); PG8_STAGE(PG8_SA(0, 0), a2, voffA);
            PG8_WAIT_V(8); PG8_WAIT_L(0); PG8_BAR; PG8_MMA(1, 0, At, B0); PG8_MMA(1, 1, At, B1); PG8_BAR; PG8_SCHED;
            PG8_LDB(B0, 1, 0); PG8_LDB(B1, 1, 1); PG8_SCHED; PG8_LDA(At, 1, 0); PG8_STAGE(PG8_SA(0, 1), a2 + hstep, voffA);
            PG8_WAIT_V(8); PG8_WAIT_L(0); PG8_BAR; PG8_MMA(0, 0, At, B0); PG8_MMA(0, 1, At, B1); PG8_BAR; PG8_SCHED;
            PG8_LDA(At, 1, 1); PG8_STAGE(PG8_SB(1, 0), b3, voffB); PG8_STAGE(PG8_SB(1, 1), b3 + hstep, voffB); PG8_STAGE(PG8_SA(1, 0), a3, voffA);
            PG8_WAIT_V(8); PG8_WAIT_L(0); PG8_BAR; PG8_MMA(1, 0, At, B0); PG8_MMA(1, 1, At, B1); PG8_BAR; PG8_SCHED;
            } else {
            PG8_LDB(B0, 0, 0); PG8_SCHED; PG8_LDA(At, 0, 0); PG8_STAGE(PG8_SA(1, 1), a1 + hstep, voffA);
            PG8_WAIT_L(8); PG8_BAR; PG8_WAIT_L(0); PG8_MMA(0, 0, At, B0); PG8_BAR; PG8_SCHED;
            PG8_LDB(B1, 0, 1); PG8_STAGE(PG8_SB(0, 0), b2, voffB);
            PG8_BAR; PG8_WAIT_L(0); PG8_MMA(0, 1, At, B1); PG8_BAR;
            PG8_LDA(At, 0, 1); PG8_STAGE(PG8_SA(0, 0), a2, voffA);
            PG8_BAR; PG8_WAIT_L(0); PG8_MMA(1, 0, At, B0); PG8_BAR; PG8_SCHED;
            PG8_STAGE(PG8_SB(0, 1), b2 + hstep, voffB);
            PG8_WAIT_V(6); PG8_BAR; PG8_MMA(1, 1, At, B1); PG8_BAR;
            PG8_LDB(B0, 1, 0); PG8_SCHED; PG8_LDA(At, 1, 0); PG8_STAGE(PG8_SA(0, 1), a2 + hstep, voffA);
            PG8_WAIT_L(8); PG8_BAR; PG8_WAIT_L(0); PG8_MMA(0, 0, At, B0); PG8_BAR; PG8_SCHED;
            PG8_LDB(B1, 1, 1); PG8_STAGE(PG8_SB(1, 0), b3, voffB);
            PG8_BAR; PG8_WAIT_L(0); PG8_MMA(0, 1, At, B1); PG8_BAR;
            PG8_LDA(At, 1, 1); PG8_STAGE(PG8_SA(1, 0), a3, voffA);
            PG8_BAR; PG8_WAIT_L(0); PG8_MMA(1, 0, At, B0); PG8_BAR; PG8_SCHED;
            PG8_STAGE(PG8_SB(1, 1), b3 + hstep, voffB);
            PG8_WAIT_V(6); PG8_BAR; PG8_MMA(1, 1, At, B1); PG8_BAR;
            }
        }
        if constexpr (ALIGN_EPI) { if (wr == 0) PG8_BAR; }
        if constexpr (!Epi::AFTER_DRAIN) { E(acc, cur, wr, wc, fr, fq); S.done(cur); }
        if (!has_next) break;
#pragma unroll
        for (int a = 0; a < 2; ++a)
#pragma unroll
            for (int b = 0; b < 2; ++b)
#pragma unroll
                for (int m = 0; m < 4; ++m)
#pragma unroll
                    for (int n = 0; n < 2; ++n) acc[a][b][m][n] = (f32x4){0.f, 0.f, 0.f, 0.f};
        cur = nxt; cA = nA; cB = nB; ++ui;
        if constexpr (ALIGN_EPI) { if (wr == 1) PG8_BAR; }
    }
    PG8_WAIT_V(0);
    if constexpr (!ALIGN_EPI) { if (wr == 0) PG8_BAR; }
    PG8_BAR;
    if constexpr (Epi::AFTER_DRAIN) { E.fused(acc, cur, wr, wc, fr, fq, lds, wid, lane); S.done(cur); }
#undef PG8_SA
#undef PG8_SB
#undef PG8_STAGE
#undef PG8_LDA
#undef PG8_LDB
#undef PG8_MMA
#undef PG8_WAIT_V
#undef PG8_WAIT_L
#undef PG8_BAR
#undef PG8_SCHED
}
}

namespace att {
typedef unsigned short bf16_t;
using bf16x8 = __attribute__((ext_vector_type(8))) short;
using s16x4  = __attribute__((ext_vector_type(4))) short;
using f32x16 = __attribute__((ext_vector_type(16))) float;
using u32x4  = __attribute__((ext_vector_type(4))) unsigned;
constexpr int D = 128, NW = 8, QBLK = 32, KVBLK = 64;
constexpr float SCALE = 0.088388347648318440f;
constexpr float THR = 8.f;
#ifndef ATT_SDEPTH
#define ATT_SDEPTH 2
#endif
#ifndef ATT_QKB
#define ATT_QKB 1
#endif
#ifndef ATT_PVB
#define ATT_PVB 1
#endif
constexpr int SDEPTH = ATT_SDEPTH;
constexpr size_t SHM_V = KVBLK * D * 2, SHM_K = KVBLK * D * 2, SHM_ATTN = 2 * SHM_V + 2 * SHM_K + NW * 64 * 4;
#define KSWZ(row, colB) ((row) * 256 + ((colB) ^ (((row) & 7) << 4)))
#define SBAR() __builtin_amdgcn_sched_barrier(0)
__device__ __forceinline__ int crow(int r, int hi) { return (r & 3) + 8 * (r >> 2) + 4 * hi; }
__device__ __forceinline__ unsigned cvtpk(float lo, float hi) { unsigned r; asm volatile("v_cvt_pk_bf16_f32 %0, %1, %2" : "=v"(r) : "v"(lo), "v"(hi)); return r; }
__device__ __forceinline__ float bf2f(short s) { return __uint_as_float(((unsigned)(unsigned short)s) << 16); }

__device__ __forceinline__ void partialSM(f32x16& p0, f32x16& p1, float& m_reg, float& mn, float& alpha) {
  constexpr float C = SCALE * 1.4426950408889634f;
  float pmax = p0[0]; for (int r = 1; r < 16; ++r) pmax = fmaxf(pmax, p0[r]); for (int r = 0; r < 16; ++r) pmax = fmaxf(pmax, p1[r]);
  { auto rr = __builtin_amdgcn_permlane32_swap(__float_as_uint(pmax), __float_as_uint(pmax), false, false);
    pmax = fmaxf(__uint_as_float(rr[0]), __uint_as_float(rr[1])); }
  if (__builtin_expect(__all(pmax - m_reg <= THR / SCALE), 1)) { mn = m_reg; alpha = 1.f; }
  else { mn = fmaxf(m_reg, pmax); alpha = __builtin_amdgcn_exp2f((m_reg - mn) * C); m_reg = mn; }
  float mnC = -mn * C;
  for (int r = 0; r < 16; ++r) p0[r] = fmaf(p0[r], C, mnC); for (int r = 0; r < 16; ++r) p1[r] = fmaf(p1[r], C, mnC);
  for (int r = 0; r < 16; ++r) p0[r] = __builtin_amdgcn_exp2f(p0[r]);
}
__device__ __forceinline__ void smfix(f32x16& p0, f32x16& p1, float nB) {
  constexpr float C = SCALE * 1.4426950408889634f;
  for (int r = 0; r < 16; ++r) p0[r] = fmaf(p0[r], C, nB); for (int r = 0; r < 16; ++r) p1[r] = fmaf(p1[r], C, nB);
  for (int r = 0; r < 16; ++r) p0[r] = __builtin_amdgcn_exp2f(p0[r]);
}
__device__ __forceinline__ void finishSM(f32x16& p0, f32x16& p1, float alpha, float& l_reg, bf16x8& pa0, bf16x8& pa1, bf16x8& pa2, bf16x8& pa3) {
  for (int r = 0; r < 16; ++r) p1[r] = __builtin_amdgcn_exp2f(p1[r]);
  float ps = 0; for (int r = 0; r < 16; ++r) ps += p0[r]; for (int r = 0; r < 16; ++r) ps += p1[r];
  { auto rr = __builtin_amdgcn_permlane32_swap(__float_as_uint(ps), __float_as_uint(ps), false, false);
    ps = __uint_as_float(rr[0]) + __uint_as_float(rr[1]); }
  l_reg = l_reg * alpha + ps;
#define PK4(P, BASE, OUT) do { unsigned a0 = cvtpk(P[BASE + 0], P[BASE + 1]), a1 = cvtpk(P[BASE + 2], P[BASE + 3]);   \
    unsigned b0 = cvtpk(P[BASE + 4], P[BASE + 5]), b1 = cvtpk(P[BASE + 6], P[BASE + 7]);                              \
    auto r0 = __builtin_amdgcn_permlane32_swap(a0, b0, false, false); auto r1 = __builtin_amdgcn_permlane32_swap(a1, b1, false, false); \
    u32x4 w = {r0[0], r1[0], r0[1], r1[1]}; OUT = *reinterpret_cast<bf16x8*>(&w); } while (0)
  PK4(p0, 0, pa0); PK4(p0, 8, pa1); PK4(p1, 0, pa2); PK4(p1, 8, pa3);
#undef PK4
}
__device__ __forceinline__ void qkt(f32x16& p0, f32x16& p1, const char* Ks, const bf16x8* qr, int r32, int hi) {
  p0 = f32x16{}; p1 = f32x16{};
#if ATT_QKB == 1
  for (int d0 = 0; d0 < 8; ++d0) { int cb = (d0 * 16 + hi * 8) * 2;
    bf16x8 b0 = *reinterpret_cast<const bf16x8*>(Ks + KSWZ(r32, cb));
    bf16x8 b1 = *reinterpret_cast<const bf16x8*>(Ks + KSWZ(32 + r32, cb));
    p0 = __builtin_amdgcn_mfma_f32_32x32x16_bf16(b0, qr[d0], p0, 0, 0, 0);
    p1 = __builtin_amdgcn_mfma_f32_32x32x16_bf16(b1, qr[d0], p1, 0, 0, 0); }
#else
#pragma unroll
  for (int d0 = 0; d0 < 8; d0 += ATT_QKB) { bf16x8 b0[ATT_QKB], b1[ATT_QKB];
#pragma unroll
    for (int t = 0; t < ATT_QKB; ++t) { const int cb = ((d0 + t) * 16 + hi * 8) * 2;
      b0[t] = *reinterpret_cast<const bf16x8*>(Ks + KSWZ(r32, cb)); b1[t] = *reinterpret_cast<const bf16x8*>(Ks + KSWZ(32 + r32, cb)); }
    asm volatile("s_waitcnt lgkmcnt(0)" ::: "memory"); SBAR();
#pragma unroll
    for (int t = 0; t < ATT_QKB; ++t) { p0 = __builtin_amdgcn_mfma_f32_32x32x16_bf16(b0[t], qr[d0 + t], p0, 0, 0, 0); p1 = __builtin_amdgcn_mfma_f32_32x32x16_bf16(b1[t], qr[d0 + t], p1, 0, 0, 0); }
    SBAR(); }
#endif
}
__device__ __forceinline__ int v_st(int k, int c) { const int kk = (k & ~0xC) | ((k & 4) << 1) | ((k & 8) >> 1); return ((kk >> 3) * 4 + (c >> 5)) * 512 + ((kk & 7) * 32 + (c & 31)) * 2; }
__device__ __forceinline__ int v_rd_base(int lane) { return ((lane & 3) << 3) | (((lane >> 2) & 3) << 6) | (((lane >> 4) & 1) << 5) | (((lane >> 5) & 1) << 8); }
constexpr int v_rd_off(int d0, int ks, int half) { return d0 * 512 + ks * 4096 + half * 2048; }
template <int OFF> __device__ __forceinline__ s16x4 tr_read(int vb) {
  s16x4 r; asm volatile("ds_read_b64_tr_b16 %0, %1 offset:%2" : "=&v"(r) : "v"(vb), "i"(OFF) : "memory"); return r;
}
template <int D0> __device__ __forceinline__ void pv_one(f32x16& od, int vb, bf16x8 pa0, bf16x8 pa1, bf16x8 pa2, bf16x8 pa3) {
  const s16x4 l0 = tr_read<v_rd_off(D0, 0, 0)>(vb), h0 = tr_read<v_rd_off(D0, 0, 1)>(vb), l1 = tr_read<v_rd_off(D0, 1, 0)>(vb), h1 = tr_read<v_rd_off(D0, 1, 1)>(vb);
  const s16x4 l2 = tr_read<v_rd_off(D0, 2, 0)>(vb), h2 = tr_read<v_rd_off(D0, 2, 1)>(vb), l3 = tr_read<v_rd_off(D0, 3, 0)>(vb), h3 = tr_read<v_rd_off(D0, 3, 1)>(vb);
  asm volatile("s_waitcnt lgkmcnt(0)" ::: "memory"); SBAR();
#define PK(L, H) (bf16x8){L[0], L[1], L[2], L[3], H[0], H[1], H[2], H[3]}
  od = __builtin_amdgcn_mfma_f32_32x32x16_bf16(pa0, PK(l0, h0), od, 0, 0, 0);
  od = __builtin_amdgcn_mfma_f32_32x32x16_bf16(pa1, PK(l1, h1), od, 0, 0, 0);
  od = __builtin_amdgcn_mfma_f32_32x32x16_bf16(pa2, PK(l2, h2), od, 0, 0, 0);
  od = __builtin_amdgcn_mfma_f32_32x32x16_bf16(pa3, PK(l3, h3), od, 0, 0, 0);
#undef PK
}
template <int D0> __device__ __forceinline__ void pv_two(f32x16& oa, f32x16& ob, int vb, bf16x8 pa0, bf16x8 pa1, bf16x8 pa2, bf16x8 pa3) {
  const s16x4 l0 = tr_read<v_rd_off(D0, 0, 0)>(vb), h0 = tr_read<v_rd_off(D0, 0, 1)>(vb), l1 = tr_read<v_rd_off(D0, 1, 0)>(vb), h1 = tr_read<v_rd_off(D0, 1, 1)>(vb);
  const s16x4 l2 = tr_read<v_rd_off(D0, 2, 0)>(vb), h2 = tr_read<v_rd_off(D0, 2, 1)>(vb), l3 = tr_read<v_rd_off(D0, 3, 0)>(vb), h3 = tr_read<v_rd_off(D0, 3, 1)>(vb);
  const s16x4 m0 = tr_read<v_rd_off(D0 + 1, 0, 0)>(vb), g0 = tr_read<v_rd_off(D0 + 1, 0, 1)>(vb), m1 = tr_read<v_rd_off(D0 + 1, 1, 0)>(vb), g1 = tr_read<v_rd_off(D0 + 1, 1, 1)>(vb);
  const s16x4 m2 = tr_read<v_rd_off(D0 + 1, 2, 0)>(vb), g2 = tr_read<v_rd_off(D0 + 1, 2, 1)>(vb), m3 = tr_read<v_rd_off(D0 + 1, 3, 0)>(vb), g3 = tr_read<v_rd_off(D0 + 1, 3, 1)>(vb);
  asm volatile("s_waitcnt lgkmcnt(0)" ::: "memory"); SBAR();
#define PK(L, H) (bf16x8){L[0], L[1], L[2], L[3], H[0], H[1], H[2], H[3]}
  oa = __builtin_amdgcn_mfma_f32_32x32x16_bf16(pa0, PK(l0, h0), oa, 0, 0, 0);
  ob = __builtin_amdgcn_mfma_f32_32x32x16_bf16(pa0, PK(m0, g0), ob, 0, 0, 0);
  oa = __builtin_amdgcn_mfma_f32_32x32x16_bf16(pa1, PK(l1, h1), oa, 0, 0, 0);
  ob = __builtin_amdgcn_mfma_f32_32x32x16_bf16(pa1, PK(m1, g1), ob, 0, 0, 0);
  oa = __builtin_amdgcn_mfma_f32_32x32x16_bf16(pa2, PK(l2, h2), oa, 0, 0, 0);
  ob = __builtin_amdgcn_mfma_f32_32x32x16_bf16(pa2, PK(m2, g2), ob, 0, 0, 0);
  oa = __builtin_amdgcn_mfma_f32_32x32x16_bf16(pa3, PK(l3, h3), oa, 0, 0, 0);
  ob = __builtin_amdgcn_mfma_f32_32x32x16_bf16(pa3, PK(m3, g3), ob, 0, 0, 0);
#undef PK
}
__device__ __forceinline__ void pv_d0(f32x16* o, int vb, bf16x8 pa0, bf16x8 pa1, bf16x8 pa2, bf16x8 pa3) {
#if ATT_PVB == 2
  pv_two<0>(o[0], o[1], vb, pa0, pa1, pa2, pa3); pv_two<2>(o[2], o[3], vb, pa0, pa1, pa2, pa3);
#else
  pv_one<0>(o[0], vb, pa0, pa1, pa2, pa3); pv_one<1>(o[1], vb, pa0, pa1, pa2, pa3); pv_one<2>(o[2], vb, pa0, pa1, pa2, pa3); pv_one<3>(o[3], vb, pa0, pa1, pa2, pa3);
#endif
}
__device__ __forceinline__ void wmask(f32x16& p0, f32x16& p1, int kb, int qpos, int hi) {
#pragma unroll
  for (int r = 0; r < 16; ++r) { const int k0 = kb + crow(r, hi), k1 = k0 + 32;
    const bool ok0 = (unsigned)(k0 - qpos + 128) <= 256u && (unsigned)k0 < 4096u, ok1 = (unsigned)(k1 - qpos + 128) <= 256u && (unsigned)k1 < 4096u;
    p0[r] = ok0 ? p0[r] : -1e30f; p1[r] = ok1 ? p1[r] : -1e30f; }
}
struct UnitArgs {
  int qrow0;
  int qcol;
  int kvbase;
  int kstart;
  int NT;
  int tpos0;
  int rope;
  int ocol;
  float sinkl2;
  float nB;
  int has_sink;
};
template <int LDP, bool WINDOW, bool FIXED>
__device__ __forceinline__ void attn_unit(const bf16_t* __restrict__ P, const bf16_t* __restrict__ KC, const bf16_t* __restrict__ VC, bf16_t* __restrict__ CAT, const float* qg, const UnitArgs a, char* lds) {
  constexpr int SD = FIXED ? 1 : SDEPTH;
  int tid_ = threadIdx.x; asm volatile("" : "+v"(tid_));
  { __attribute__((address_space(1))) const float* qg1 = (__attribute__((address_space(1))) const float*)qg; asm volatile("" : "+s"(qg1)); qg = (const float*)qg1; }
  const int tid = tid_, wid = tid >> 6, lane = tid & 63, r32 = lane & 31, hi = lane >> 5;
  char* V_lds = lds; char* K_lds = lds + 3 * SHM_V;
  float* ws = (float*)(lds + 3 * SHM_V + 3 * SHM_K) + wid * 64; float* li_l = ws; float* al_l = ws + 32;
  float m_reg = -1e30f, l_reg = 0; f32x16 o[4] = {}; bf16x8 qr[8];
  const int qpos = a.tpos0 + wid * QBLK + r32;
  const int sr = tid >> 4, sc = (tid & 15) * 8, vst0 = v_st(sr, sc), vst1 = v_st(32 + sr, sc);
  const int vb0 = (int)(uintptr_t)V_lds + v_rd_base(lane);
  struct { bf16x8 vs0, vs1, ks0, ks1; } sr_[SD];
  const bf16_t* Kc = KC + a.kvbase + sc; const bf16_t* Vc = VC + a.kvbase + sc;
#define TROW(jt) ((jt) < 4 ? 64 * (jt) : max(256 + a.kstart + 64 * ((jt) - 4), 0))
#define SLOAD(i, jt) do { const size_t _r0 = (size_t)(TROW(jt) + sr) * 128; const size_t _r1 = _r0 + (size_t)32 * 128; \
    sr_[i].vs0 = *reinterpret_cast<const bf16x8*>(Vc + _r0); sr_[i].vs1 = *reinterpret_cast<const bf16x8*>(Vc + _r1); \
    sr_[i].ks0 = *reinterpret_cast<const bf16x8*>(Kc + _r0); sr_[i].ks1 = *reinterpret_cast<const bf16x8*>(Kc + _r1); } while (0)
  SLOAD(0, 0);
  {
    const bf16_t* Qw = P + (size_t)(a.qrow0 + wid * QBLK + r32) * LDP + a.qcol + hi * 8;
    bf16x8 raw[8];
#pragma unroll
    for (int d0 = 0; d0 < 8; ++d0) raw[d0] = *reinterpret_cast<const bf16x8*>(Qw + d0 * 16);
    float ss = 0.f;
#pragma unroll
    for (int d0 = 0; d0 < 8; ++d0)
#pragma unroll
      for (int e = 0; e < 8; ++e) { const float f = bf2f(raw[d0][e]); ss += f * f; }
    { auto rr = __builtin_amdgcn_permlane32_swap(__float_as_uint(ss), __float_as_uint(ss), false, false); ss = __uint_as_float(rr[0]) + __uint_as_float(rr[1]); }
    const float rstd = 1.0f / sqrtf(ss * (1.0f / 128.0f) + 1e-6f);
    const float pr = (float)(qpos >> 6), pc = (float)(qpos & 63);
#pragma unroll
    for (int ax = 0; ax < 2; ++ax)
#pragma unroll
      for (int dd = 0; dd < 2; ++dd) { const int da = ax * 4 + dd, db = da + 2; float x1[8], x2[8];
        const float* ga = qg + da * 16 + hi * 8; const float* gb = qg + db * 16 + hi * 8;
#pragma unroll
        for (int e = 0; e < 8; ++e) { x1[e] = bf2f(raw[da][e]) * rstd * ga[e]; x2[e] = bf2f(raw[db][e]) * rstd * gb[e]; }
        if (a.rope) { const float pos = ax == 0 ? pr : pc;
#pragma unroll
          for (int e = 0; e < 8; ++e) { const int i = dd * 16 + hi * 8 + e; const float inv = __builtin_amdgcn_exp2f(-(float)i * 0.41524101186092029f);
            const float an = pos * inv, c = __cosf(an), s = __sinf(an), y1 = x1[e] * c - x2[e] * s, y2 = x2[e] * c + x1[e] * s; x1[e] = y1; x2[e] = y2; } }
        { u32x4 w = {cvtpk(x1[0], x1[1]), cvtpk(x1[2], x1[3]), cvtpk(x1[4], x1[5]), cvtpk(x1[6], x1[7])}; qr[da] = *reinterpret_cast<bf16x8*>(&w); }
        { u32x4 w = {cvtpk(x2[0], x2[1]), cvtpk(x2[2], x2[3]), cvtpk(x2[4], x2[5]), cvtpk(x2[6], x2[7])}; qr[db] = *reinterpret_cast<bf16x8*>(&w); }
        asm volatile("" ::: "memory"); }
  }
#define SWRITE(b, i) do { *(bf16x8*)(V_lds + (b) * SHM_V + vst0) = sr_[i].vs0;          \
    *(bf16x8*)(V_lds + (b) * SHM_V + vst1) = sr_[i].vs1; int kc = sc * 2;               \
    *(bf16x8*)(K_lds + (b) * SHM_K + KSWZ(sr, kc)) = sr_[i].ks0;                       \
    *(bf16x8*)(K_lds + (b) * SHM_K + KSWZ(32 + sr, kc)) = sr_[i].ks1; } while (0)
#define SWAIT() do { if constexpr (SD == 2) asm volatile("s_waitcnt vmcnt(4)" ::: "memory"); else asm volatile("s_waitcnt vmcnt(0)" ::: "memory"); } while (0)
#define RESC(al) do { if (__any((al) < 1.f)) { if (hi == 0) al_l[r32] = (al); asm volatile("s_waitcnt lgkmcnt(0)" ::: "memory"); \
    for (int d = 0; d < 4; ++d) for (int r = 0; r < 16; ++r) o[d][r] *= al_l[crow(r, hi)]; } } while (0)
#define WMASK(p0, p1, jt) do { if constexpr (WINDOW) { if ((jt) >= 4) wmask(p0, p1, a.kstart + 64 * ((jt) - 4), qpos, hi); } } while (0)
#define PSM(q0, q1, mnx, alx) do { if constexpr (FIXED) { smfix(q0, q1, a.nB); alx = 1.f; } else partialSM(q0, q1, m_reg, mnx, alx); } while (0)
  f32x16 pA0, pA1, pB0, pB1; float mnA, mnB, alA, alB; bf16x8 pa0, pa1, pa2, pa3; const int NT = a.NT;
  constexpr int SE = 0, SO = SD - 1;
  asm volatile("s_waitcnt vmcnt(0)" ::: "memory"); SWRITE(0, SE); __syncthreads();
  qkt(pA0, pA1, K_lds, qr, r32, hi); PSM(pA0, pA1, mnA, alA);
  SLOAD(SO, 1); if constexpr (SD == 2) { if (2 < NT) SLOAD(SE, 2); }
  SWAIT(); SWRITE(1, SO); __syncthreads();
  int bprev = 0, bcur = 1, bnext = 2;
#define ROT() do { bprev = bcur; bcur = bnext; bnext = (bnext == 2) ? 0 : bnext + 1; } while (0)
  for (int j = 1; j + 1 < NT; j += 2) {
    SBAR(); qkt(pB0, pB1, K_lds + bcur * (int)SHM_K, qr, r32, hi);
    finishSM(pA0, pA1, alA, l_reg, pa0, pa1, pa2, pa3); SBAR();
    SLOAD(SO, j + SD); SBAR();
    pv_d0(o, vb0 + bprev * (int)SHM_V, pa0, pa1, pa2, pa3); WMASK(pB0, pB1, j); PSM(pB0, pB1, mnB, alB);
    SWAIT(); SWRITE(bnext, SE);
    if constexpr (!FIXED) RESC(alB); __syncthreads(); ROT();
    SBAR(); qkt(pA0, pA1, K_lds + bcur * (int)SHM_K, qr, r32, hi);
    finishSM(pB0, pB1, alB, l_reg, pa0, pa1, pa2, pa3); SBAR();
    if (SD == 1 || j + 3 < NT) SLOAD(SE, j + 1 + SD); SBAR();
    pv_d0(o, vb0 + bprev * (int)SHM_V, pa0, pa1, pa2, pa3); WMASK(pA0, pA1, j + 1); PSM(pA0, pA1, mnA, alA);
    SWAIT(); SWRITE(bnext, SO);
    if constexpr (!FIXED) RESC(alA); __syncthreads(); ROT();
  }
  SBAR(); qkt(pB0, pB1, K_lds + bcur * (int)SHM_K, qr, r32, hi);
  finishSM(pA0, pA1, alA, l_reg, pa0, pa1, pa2, pa3); SBAR();
  pv_d0(o, vb0 + bprev * (int)SHM_V, pa0, pa1, pa2, pa3); WMASK(pB0, pB1, NT - 1); PSM(pB0, pB1, mnB, alB);
  if constexpr (!FIXED) RESC(alB);
  finishSM(pB0, pB1, alB, l_reg, pa0, pa1, pa2, pa3); SBAR();
  pv_d0(o, vb0 + bcur * (int)SHM_V, pa0, pa1, pa2, pa3);
#undef ROT
  if (a.has_sink) l_reg += __builtin_amdgcn_exp2f(FIXED ? a.sinkl2 + a.nB : a.sinkl2 - m_reg * (SCALE * 1.4426950408889634f));
#undef PSM
  if (hi == 0) li_l[r32] = l_reg; asm volatile("s_waitcnt lgkmcnt(0)" ::: "memory");
  float rli[16];
#pragma unroll
  for (int r = 0; r < 16; ++r) rli[r] = __builtin_amdgcn_rcpf(li_l[crow(r, hi)]);
  bf16_t* Ow = CAT + (size_t)(a.qrow0 + wid * QBLK) * 2048 + a.ocol + r32;
#pragma unroll
  for (int r = 0; r < 16; ++r) { const int orow = crow(r, hi);
#pragma unroll
    for (int d0 = 0; d0 < 4; ++d0) { const float v = o[d0][r] * rli[r]; Ow[(size_t)orow * 2048 + d0 * 32] = (bf16_t)(cvtpk(v, v) & 0xffffu); } }
#undef TROW
#undef SLOAD
#undef SWRITE
#undef SWAIT
#undef RESC
#undef WMASK
}
}

namespace cg = cooperative_groups;
typedef unsigned short bf16_t;
typedef float f32x4 __attribute__((ext_vector_type(4)));
typedef float f32x2 __attribute__((ext_vector_type(2)));
typedef unsigned u32x4 __attribute__((ext_vector_type(4)));
typedef unsigned u32x2 __attribute__((ext_vector_type(2)));
typedef short bf16x8 __attribute__((ext_vector_type(8)));
typedef short s16x4 __attribute__((ext_vector_type(4)));

constexpr int DM = 2048, SEQ = 4096, NB = 4, CTXL = 256, FFN = 5632, NMOD = 12288;
constexpr int MLAT = NB * SEQ, MCTX = NB * CTXL, MALL = MLAT + MCTX;
constexpr int LDP0 = 4096, LDP1 = 3072;
constexpr float EPS = 1e-6f;
constexpr size_t MiB = 1u << 20;
constexpr size_t WS_BAR = 512 * 1024, BAR_BYTES = 16384, WS_CNT = 640 * 1024, WS_CNTX = 768 * 1024, ZERO_BYTES = 1u << 20;
constexpr size_t WS_MOD = 0, WS_W0IN = 1 * MiB, WS_W0OUT = 17 * MiB, WS_W0GU = 25 * MiB, WS_W0DN = 69 * MiB, WS_W1IN = 91 * MiB, WS_W1OUT = 103 * MiB, WS_W1GU = 111 * MiB, WS_W1DN = 155 * MiB;
constexpr size_t WS_XN = 177 * MiB, WS_H = 245 * MiB, WS_PROJ = 381 * MiB, WS_CAT = 517 * MiB, WS_HID = WS_PROJ, WS_PP = 585 * MiB, WS_KC = 617 * MiB, WS_VC = 634 * MiB, WS_SSX = 652 * MiB, WS_END = 656 * MiB;
static_assert(WS_HID + (size_t)MALL * FFN * 2 <= WS_END && WS_CAT + (size_t)MALL * DM * 2 <= WS_END && WS_PROJ + (size_t)MALL * LDP0 * 2 <= WS_CAT, "ws map");
constexpr int NWAVES = 8, NTHR = 512;
constexpr int LDS_BYTES = 147456;

#define LAS __attribute__((address_space(3)))
#define XB_TMO      128
#define XB_XCNT(j)  (256  + 64 * (j))
#define XB_XSUB(j)  (1280 + 64 * (j))
#define XB_XGEN(j)  (2304 + 64 * (j))
#define XB_TOP      3328
#define XB_TOPGEN   3392
#define XCD_BAR_WORDS 3456
#define XB_SPIN_CAP (1u << 18)

__device__ __forceinline__ unsigned xb_ld(unsigned* p)              { return __hip_atomic_load(p, __ATOMIC_RELAXED, __HIP_MEMORY_SCOPE_AGENT); }
__device__ __forceinline__ unsigned xb_add(unsigned* p, unsigned v) { return __hip_atomic_fetch_add(p, v, __ATOMIC_RELAXED, __HIP_MEMORY_SCOPE_AGENT); }
__device__ __forceinline__ unsigned xb_xcc_id() { return (unsigned)__builtin_amdgcn_s_getreg((3 << 11) | 20) & 0xFu; }
#define XB_SPIN(cond, bar) do { unsigned _sp = 0; while (cond) { __builtin_amdgcn_s_sleep(1); \
    if ((++_sp & 255u) == 0u) { if (xb_ld(&(bar)[XB_TMO])) break; if (_sp > XB_SPIN_CAP) { atomicAdd(&(bar)[XB_TMO], 1u); break; } } } } while (0)

struct XcdBarrier {
    unsigned* bar; unsigned x;
    volatile LAS unsigned* st;
};

__device__ __forceinline__ XcdBarrier xcd_barrier_post(unsigned* bar, volatile LAS unsigned* st) {
    XcdBarrier b; b.bar = bar; b.x = xb_xcc_id(); b.st = st;
    if (threadIdx.x == 0) (void)xb_add(&bar[XB_XCNT(b.x)], 1u);
    return b;
}
__device__ __forceinline__ void xcd_barrier_complete(unsigned* bar, unsigned x, unsigned& nloc, unsigned& nx) {
    const unsigned G = gridDim.x * gridDim.y * gridDim.z;
    unsigned sum, cnt, mine, sp = 0u;
    for (;;) {
        sum = 0u; cnt = 0u; mine = 0u;
#pragma unroll
        for (unsigned j = 0; j < 16; ++j) { const unsigned c = xb_ld(&bar[XB_XCNT(j)]); sum += c; cnt += (c > 0u) ? 1u : 0u; mine = (j == x) ? c : mine; }
        if (sum == G) break;
        __builtin_amdgcn_s_sleep(1);
        if ((++sp & 255u) == 0u) { if (xb_ld(&bar[XB_TMO])) break; if (sp > XB_SPIN_CAP) { atomicAdd(&bar[XB_TMO], 1u); break; } }
    }
    nloc = mine > 0u ? mine : 1u; nx = cnt > 0u ? cnt : 1u;
}

__device__ __forceinline__ void xcd_barrier(const XcdBarrier& b) {
    asm volatile("s_waitcnt vmcnt(0)" ::: "memory");
    __syncthreads();
    if (threadIdx.x == 0) {
        unsigned* bar; { __attribute__((address_space(1))) unsigned* b1 = (__attribute__((address_space(1))) unsigned*)b.bar; asm volatile("" : "+s"(b1)); bar = (unsigned*)b1; }
        __builtin_amdgcn_s_waitcnt(0);
        unsigned nloc = b.st[0], nx = b.st[1];
        if (nloc == 0u) { unsigned bx0 = b.x; asm volatile("" : "+s"(bx0)); xcd_barrier_complete(bar, bx0, nloc, nx); b.st[0] = nloc; b.st[1] = nx; }
        unsigned bx = b.x; asm volatile("" : "+s"(bx));
        const unsigned old = xb_add(&bar[XB_XSUB(bx)], 1u);
        const unsigned gen = old / nloc;
        if (old + 1u == (gen + 1u) * nloc) {
            __builtin_amdgcn_fence(__ATOMIC_RELEASE, "agent");
            asm volatile("s_waitcnt vmcnt(0)" ::: "memory");
            const unsigned og = xb_add(&bar[XB_TOP], 1u);
            const unsigned tg = og / nx;
            if (og + 1u == (tg + 1u) * nx) xb_add(&bar[XB_TOPGEN], 1u);
            else XB_SPIN(xb_ld(&bar[XB_TOPGEN]) == tg, bar);
            __builtin_amdgcn_fence(__ATOMIC_ACQUIRE, "agent");
            xb_add(&bar[XB_XGEN(bx)], 1u);
            asm volatile("s_waitcnt vmcnt(0)" ::: "memory");
        } else {
            XB_SPIN(xb_ld(&bar[XB_XGEN(bx)]) == gen, bar);
            __builtin_amdgcn_fence(__ATOMIC_ACQUIRE, "agent");
            asm volatile("s_waitcnt vmcnt(0)" ::: "memory");
        }
    }
    __syncthreads();
}

struct Args {
  const float *x, *c, *ctx, *c_ctx;
  const float *l0_norm1_g, *l0_w_mod, *l0_b_mod, *l0_w_in, *l0_q_g, *l0_k_g, *l0_conv_w, *l0_w_out, *l0_norm2_g, *l0_w_gate, *l0_w_up, *l0_w_down;
  const float *l1_norm1_g, *l1_w_mod, *l1_b_mod, *l1_w_in, *l1_q_g, *l1_k_g, *l1_sink, *l1_pool_w, *l1_pool_scale, *l1_w_out, *l1_norm2_g, *l1_w_gate, *l1_w_up, *l1_w_down;
  const float *final_g;
  float* out; unsigned char* ws;
};

__device__ __forceinline__ float wave_sum(float v) {
#pragma unroll
  for (int o = 1; o < 64; o <<= 1) v += __shfl_xor(v, o);
  return v;
}
__device__ __forceinline__ unsigned pk2(float lo, float hi) { return pg8::cvt_pk_bf16(lo, hi); }
__device__ __forceinline__ float bf2f(unsigned short s) { return __uint_as_float(((unsigned)s) << 16); }
__device__ __forceinline__ float silu(float x) { return x / (1.0f + __expf(-x)); }

template <int MODE>
__device__ __forceinline__ void tr_item(const float* __restrict__ W, int N, bf16_t* __restrict__ WT, int ldk, int item, int lane) {
  const int nblk = N >> 6, kb = item / nblk, nb = item - kb * nblk, k0 = kb * 64, n = nb * 64 + lane;
  const int drow = MODE == 0 ? n : ((n >> 7) * 256 + (n & 127) + (MODE == 2 ? 128 : 0));
  const float* src = W + (size_t)k0 * N + n; bf16_t* dst = WT + (size_t)drow * ldk + k0;
  float v[64];
#pragma unroll
  for (int i = 0; i < 64; ++i) v[i] = __builtin_nontemporal_load(src + (size_t)i * N);
#pragma unroll
  for (int c = 0; c < 8; ++c) { u32x4 w; w.x = pk2(v[8 * c], v[8 * c + 1]); w.y = pk2(v[8 * c + 2], v[8 * c + 3]); w.z = pk2(v[8 * c + 4], v[8 * c + 5]); w.w = pk2(v[8 * c + 6], v[8 * c + 7]);
    *(u32x4*)(dst + c * 8) = w; }
}

template <bool PART, bool SRC_BF16>
__device__ __forceinline__ void norm_mod_rows(const void* __restrict__ src_lat, const void* __restrict__ src_ctx, int nrows, const float* __restrict__ g, const float* __restrict__ mod, int so, int sco,
                                              bf16_t* __restrict__ XN, int gw, int ngw, int lane, const float* __restrict__ part = nullptr, const float* __restrict__ pgate = nullptr, int row0 = 0) {
  asm volatile("" : "+v"(lane));
  for (int row = row0 + gw; row < nrows; row += ngw) {
    const size_t xoff = row < MLAT ? (size_t)row * DM : (size_t)(row - MLAT) * DM; const void* xb = row < MLAT ? src_lat : src_ctx;
    const float* mr = mod + (row < MLAT ? (row >> 12) : 4) * NMOD;
    f32x4 v[8]; float ss = 0.f;
#pragma unroll
    for (int j = 0; j < 8; ++j) {
      if constexpr (SRC_BF16) { const u32x2 w = ((const u32x2*)((const bf16_t*)xb + xoff))[lane + 64 * j]; v[j] = (f32x4){__uint_as_float(w.x << 16), __uint_as_float(w.x & 0xffff0000u), __uint_as_float(w.y << 16), __uint_as_float(w.y & 0xffff0000u)}; }
      else v[j] = ((const f32x4*)((const float*)xb + xoff))[lane + 64 * j];
      if (PART && row >= MLAT) { const float* pr = part + (size_t)(row - MLAT) * DM + 4 * (lane + 64 * j); const f32x4 ps = (*(const f32x4*)pr + *(const f32x4*)(pr + (size_t)1024 * DM)) + (*(const f32x4*)(pr + (size_t)2048 * DM) + *(const f32x4*)(pr + (size_t)3072 * DM));
        v[j] += *(const f32x4*)(pgate + 4 * (lane + 64 * j)) * ps; }
      ss += (v[j].x * v[j].x + v[j].y * v[j].y) + (v[j].z * v[j].z + v[j].w * v[j].w); }
    const float rstd = 1.0f / sqrtf(wave_sum(ss) * (1.0f / DM) + EPS);
    u32x2* o8 = (u32x2*)(XN + (size_t)row * DM) + lane;
#pragma unroll
    for (int j = 0; j < 8; ++j) { const int col = 4 * (lane + 64 * j); const f32x4 gg = *(const f32x4*)(g + col), sc = *(const f32x4*)(mr + sco + col), sh = *(const f32x4*)(mr + so + col);
      const f32x4 y = v[j] * rstd * gg * (1.0f + sc) + sh; u32x2 w; w.x = pk2(y.x, y.y); w.y = pk2(y.z, y.w); o8[64 * j] = w; }
  }
}
__device__ __forceinline__ void final_norm_rows(const float* H, const float* __restrict__ g, float* out, int gw, int ngw, int lane) {
  asm volatile("" : "+v"(lane));
  for (int row = gw; row < MLAT; row += ngw) {
    const float* xr = H + (size_t)row * DM; f32x4 v[8]; float ss = 0.f;
#pragma unroll
    for (int j = 0; j < 8; ++j) { v[j] = ((const f32x4*)xr)[lane + 64 * j]; ss += (v[j].x * v[j].x + v[j].y * v[j].y) + (v[j].z * v[j].z + v[j].w * v[j].w); }
    const float rstd = 1.0f / sqrtf(wave_sum(ss) * (1.0f / DM) + EPS);
    f32x4* o = (f32x4*)(out + (size_t)row * DM) + lane;
#pragma unroll
    for (int j = 0; j < 8; ++j) { const f32x4 gg = *(const f32x4*)(g + 4 * (lane + 64 * j)); o[64 * j] = v[j] * rstd * gg; }
  }
}
template <int LDP>
__device__ __forceinline__ void knorm_row(const bf16_t* __restrict__ P, bf16_t* __restrict__ KC, bf16_t* __restrict__ VC, int row, const float* __restrict__ kg, int lane) {
  const int head = lane >> 4, s = lane & 15, half = s >> 3, i4 = (s & 7) * 4, d1 = half * 64 + i4;
  const bf16_t* p = P + (size_t)row * LDP + 1536 + head * 128 + d1;
  const int kb = row < MLAT ? (row >> 12) : ((row - MLAT) >> 8), kpos = row < MLAT ? 256 + (row & (SEQ - 1)) : ((row - MLAT) & (CTXL - 1));
  const size_t kvo = ((size_t)(kb * 4 + head) * 4352 + kpos) * 128;
  const u32x2 a = *(const u32x2*)p, b = *(const u32x2*)(p + 32);
  float x1[4] = {__uint_as_float(a.x << 16), __uint_as_float(a.x & 0xffff0000u), __uint_as_float(a.y << 16), __uint_as_float(a.y & 0xffff0000u)};
  float x2[4] = {__uint_as_float(b.x << 16), __uint_as_float(b.x & 0xffff0000u), __uint_as_float(b.y << 16), __uint_as_float(b.y & 0xffff0000u)};
  float ss = 0.f;
#pragma unroll
  for (int e = 0; e < 4; ++e) ss += x1[e] * x1[e] + x2[e] * x2[e];
  ss += __shfl_xor(ss, 1); ss += __shfl_xor(ss, 2); ss += __shfl_xor(ss, 4); ss += __shfl_xor(ss, 8);
  const float rstd = 1.0f / sqrtf(ss * (1.0f / 128.0f) + EPS);
  const f32x4 g1 = *(const f32x4*)(kg + d1), g2 = *(const f32x4*)(kg + d1 + 32);
#pragma unroll
  for (int e = 0; e < 4; ++e) { x1[e] *= rstd * g1[e]; x2[e] *= rstd * g2[e]; }
  if (row < MLAT) {
    const int t = row & (SEQ - 1); const float pos = (float)(half == 0 ? (t >> 6) : (t & 63));
#pragma unroll
    for (int e = 0; e < 4; ++e) { const float inv = __builtin_amdgcn_exp2f(-(float)(i4 + e) * 0.41524101186092029f), an = pos * inv, c = __cosf(an), sn = __sinf(an);
      const float y1 = x1[e] * c - x2[e] * sn, y2 = x2[e] * c + x1[e] * sn; x1[e] = y1; x2[e] = y2; }
  }
  u32x2 oa, ob; oa.x = pk2(x1[0], x1[1]); oa.y = pk2(x1[2], x1[3]); ob.x = pk2(x2[0], x2[1]); ob.y = pk2(x2[2], x2[3]);
  *(u32x2*)(KC + kvo + d1) = oa; *(u32x2*)(KC + kvo + d1 + 32) = ob;
}
__device__ __forceinline__ void kv_ctx_from_part(const float* __restrict__ part, bf16_t* __restrict__ KC, bf16_t* __restrict__ VC, int row, const float* __restrict__ kg, int lane) {
  const int r = row - MLAT, head = lane >> 4, s = lane & 15, half = s >> 3, i4 = (s & 7) * 4, d1 = half * 64 + i4;
  const float* pk = part + (size_t)r * 1024 + head * 128 + d1; const float* pv = part + (size_t)r * 1024 + 512 + lane * 8;
  f32x4 x1 = {0.f, 0.f, 0.f, 0.f}, x2 = x1, v0 = x1, v1 = x1;
#pragma unroll
  for (int ks = 0; ks < 8; ++ks) { const size_t o = (size_t)ks * 1024 * 1024; x1 += *(const f32x4*)(pk + o); x2 += *(const f32x4*)(pk + o + 32); v0 += *(const f32x4*)(pv + o); v1 += *(const f32x4*)(pv + o + 4); }
  float ss = (x1.x * x1.x + x1.y * x1.y) + (x1.z * x1.z + x1.w * x1.w) + (x2.x * x2.x + x2.y * x2.y) + (x2.z * x2.z + x2.w * x2.w);
  ss += __shfl_xor(ss, 1); ss += __shfl_xor(ss, 2); ss += __shfl_xor(ss, 4); ss += __shfl_xor(ss, 8);
  const float rstd = 1.0f / sqrtf(ss * (1.0f / 128.0f) + EPS);
  x1 = x1 * rstd * *(const f32x4*)(kg + d1); x2 = x2 * rstd * *(const f32x4*)(kg + d1 + 32);
  const size_t kvo = ((size_t)((r >> 8) * 4 + head) * 4352 + (r & (CTXL - 1))) * 128;
  u32x2 oa, ob; oa.x = pk2(x1.x, x1.y); oa.y = pk2(x1.z, x1.w); ob.x = pk2(x2.x, x2.y); ob.y = pk2(x2.z, x2.w);
  *(u32x2*)(KC + kvo + d1) = oa; *(u32x2*)(KC + kvo + d1 + 32) = ob;
  u32x4 w; w.x = pk2(v0.x, v0.y); w.y = pk2(v0.z, v0.w); w.z = pk2(v1.x, v1.y); w.w = pk2(v1.z, v1.w);
  *(u32x4*)(VC + kvo + (lane & 15) * 8) = w;
}
__device__ __forceinline__ void bf8_to_f(const u32x4 w, float* f) {
  f[0] = __uint_as_float(w.x << 16); f[1] = __uint_as_float(w.x & 0xffff0000u); f[2] = __uint_as_float(w.y << 16); f[3] = __uint_as_float(w.y & 0xffff0000u);
  f[4] = __uint_as_float(w.z << 16); f[5] = __uint_as_float(w.z & 0xffff0000u); f[6] = __uint_as_float(w.w << 16); f[7] = __uint_as_float(w.w & 0xffff0000u);
}
__device__ __forceinline__ void conv_row(const bf16_t* __restrict__ P, bf16_t* __restrict__ CAT, int row, const float* __restrict__ cw, int lane) {
  int t, L; if (row < MLAT) { t = row & (SEQ - 1); L = SEQ; } else { t = (row - MLAT) & (CTXL - 1); L = CTXL; }
  const int c8 = lane * 8; const bf16_t* p = P + (size_t)row * LDP0 + c8;
  float gb[8], acc[8];
  bf8_to_f(*(const u32x4*)(p + 2560), gb);
#pragma unroll
  for (int e = 0; e < 8; ++e) acc[e] = 0.f;
#pragma unroll
  for (int j = 0; j < 3; ++j) { const int tt = t + j - 1; if (tt >= 0 && tt < L) { const bf16_t* q = p + (ptrdiff_t)(j - 1) * LDP0; float gc[8], u[8]; bf8_to_f(*(const u32x4*)(q + 3072), gc); bf8_to_f(*(const u32x4*)(q + 3584), u);
      const f32x4 w0 = *(const f32x4*)(cw + j * 512 + c8), w1 = *(const f32x4*)(cw + j * 512 + c8 + 4);
#pragma unroll
      for (int e = 0; e < 4; ++e) { acc[e] += w0[e] * (gc[e] * u[e]); acc[4 + e] += w1[e] * (gc[4 + e] * u[4 + e]); } } }
  u32x4 w; w.x = pk2(gb[0] * acc[0], gb[1] * acc[1]); w.y = pk2(gb[2] * acc[2], gb[3] * acc[3]); w.z = pk2(gb[4] * acc[4], gb[5] * acc[5]); w.w = pk2(gb[6] * acc[6], gb[7] * acc[7]);
  *(u32x4*)(CAT + (size_t)row * DM + 1536 + c8) = w;
}
__device__ __forceinline__ void pool_row(const bf16_t* __restrict__ P, bf16_t* __restrict__ CAT, int row, int lane) {
  const int t = row & (SEQ - 1), c8 = lane * 8, hw = 1 << (lane >> 4);
  const int lo = max(t - hw, 0), hi = min(t + hw, SEQ);
  const bf16_t* p = P + (size_t)row * LDP1 + 2560 + c8;
  float acc[8], f[8];
#pragma unroll
  for (int e = 0; e < 8; ++e) acc[e] = 0.f;
  for (int j = -8; j < 8; ++j) { const int tt = t + j; if (tt >= lo && tt < hi) { bf8_to_f(*(const u32x4*)(p + (ptrdiff_t)j * LDP1), f);
#pragma unroll
      for (int e = 0; e < 8; ++e) acc[e] += f[e]; } }
  bf8_to_f(*(const u32x4*)p, f);
  const float rn = 1.0f / (float)(hi - lo);
  u32x4 w; w.x = pk2(acc[0] * rn - f[0], acc[1] * rn - f[1]); w.y = pk2(acc[2] * rn - f[2], acc[3] * rn - f[3]); w.z = pk2(acc[4] * rn - f[4], acc[5] * rn - f[5]); w.w = pk2(acc[6] * rn - f[6], acc[7] * rn - f[7]);
  *(u32x4*)(CAT + (size_t)row * DM + 1536 + c8) = w;
}


template <int ROWS = 64>
__device__ __forceinline__ void mod_item(const float* __restrict__ Wm, const float* __restrict__ bm, const float* __restrict__ cc, const float* __restrict__ cctx, float* __restrict__ MODl, int item, unsigned char* lds) {
  int tid = threadIdx.x; asm volatile("" : "+v"(tid));
  const int lane = tid & 63, wave = __builtin_amdgcn_readfirstlane(tid >> 6), kc = item & (2048 / ROWS - 1), cb = item / (2048 / ROWS), k0 = kc * ROWS, col = cb * 2048 + wave * 256 + lane * 4;
  float* S = (float*)lds;
  if (tid < 5 * ROWS) { const int r = tid / ROWS, k = k0 + (tid % ROWS); S[tid] = silu(r < 4 ? cc[r * 2048 + k] : cctx[k]); }
  __syncthreads();
  f32x4 acc[5];
#pragma unroll
  for (int r = 0; r < 5; ++r) acc[r] = (f32x4){0.f, 0.f, 0.f, 0.f};
  const float* wp = Wm + (size_t)k0 * NMOD + col;
#pragma unroll 1
  for (int k = 0; k < ROWS; k += 16) { f32x4 w[16];
#pragma unroll
    for (int i = 0; i < 16; ++i) w[i] = __builtin_nontemporal_load((const f32x4*)(wp + (size_t)(k + i) * NMOD));
#pragma unroll
    for (int i = 0; i < 16; ++i)
#pragma unroll
      for (int r = 0; r < 5; ++r) acc[r] += S[r * ROWS + k + i] * w[i]; }
  f32x4 bias = {0.f, 0.f, 0.f, 0.f}; if (kc == 0) bias = *(const f32x4*)(bm + col);
#pragma unroll
  for (int r = 0; r < 5; ++r)
#pragma unroll
    for (int e = 0; e < 4; ++e) __hip_atomic_fetch_add(MODl + (size_t)r * NMOD + col + e, acc[r][e] + bias[e], __ATOMIC_RELAXED, __HIP_MEMORY_SCOPE_AGENT);
  __syncthreads();
}
__device__ __forceinline__ void fold_item(const float* __restrict__ wout, const float* __restrict__ pscale, const float* __restrict__ poolw, bf16_t* __restrict__ W1OUT, int it, unsigned char* lds) {
  int tid = threadIdx.x; asm volatile("" : "+v"(tid));
  const int lane = tid & 63, wave = __builtin_amdgcn_readfirstlane(tid >> 6), g = it >> 5, n0 = (it & 31) * 64;
  float* Ws = (float*)lds;
  for (int i = tid; i < 8192; i += NTHR) { const int d = i >> 6, nn = i & 63; Ws[i] = wout[(size_t)(1536 + g * 128 + d) * DM + n0 + nn] * pscale[g * 128 + d]; }
  __syncthreads();
  float acc[16];
#pragma unroll
  for (int i = 0; i < 16; ++i) acc[i] = 0.f;
  float* PW = (float*)(lds + 32768) + wave * 2048;
  { const float* pw = poolw + (size_t)(g * 128 + wave * 16) * 128;
#pragma unroll 8
    for (int j = 0; j < 32; ++j) PW[lane + 64 * j] = pw[lane + 64 * j]; }
  asm volatile("s_waitcnt vmcnt(0) lgkmcnt(0)" ::: "memory");
  for (int d = 0; d < 128; d += 4) { const float w0 = Ws[d * 64 + lane], w1 = Ws[(d + 1) * 64 + lane], w2 = Ws[(d + 2) * 64 + lane], w3 = Ws[(d + 3) * 64 + lane];
#pragma unroll
    for (int i = 0; i < 16; ++i) { const f32x4 p = *(const f32x4*)(PW + i * 128 + d); acc[i] += (p.x * w0 + p.y * w1) + (p.z * w2 + p.w * w3); } }
  bf16_t* dst = W1OUT + (size_t)(n0 + lane) * DM + 1536 + g * 128 + wave * 16;
  u32x4 w0, w1; w0.x = pk2(acc[0], acc[1]); w0.y = pk2(acc[2], acc[3]); w0.z = pk2(acc[4], acc[5]); w0.w = pk2(acc[6], acc[7]);
  w1.x = pk2(acc[8], acc[9]); w1.y = pk2(acc[10], acc[11]); w1.z = pk2(acc[12], acc[13]); w1.w = pk2(acc[14], acc[15]);
  *(u32x4*)dst = w0; *(u32x4*)(dst + 8) = w1;
  __syncthreads();
}

__device__ __forceinline__ void attn_decode(int i, int c, int& b, int& h, int& qb) {
  const int x = c & 7, j = i * 32 + (c >> 3), pair = 2 * x + j / 48, idx = j % 48;
  b = pair >> 2; h = (pair & 3) * 3 + idx / 16; qb = idx & 15;
}

template <class T> __device__ __forceinline__ T* gptr(T* p) { __attribute__((address_space(1))) T* g = (__attribute__((address_space(1))) T*)p; asm volatile("" : "+s"(g)); return (T*)g; }
__device__ __forceinline__ unsigned char* lw(unsigned char* p) { return gptr(p); }
#define MOD   ((float*)(lw(ws) + WS_MOD))
#define W0IN  ((bf16_t*)(lw(ws) + WS_W0IN))
#define W0OUT ((bf16_t*)(lw(ws) + WS_W0OUT))
#define W0GU  ((bf16_t*)(lw(ws) + WS_W0GU))
#define W0DN  ((bf16_t*)(lw(ws) + WS_W0DN))
#define W1IN  ((bf16_t*)(lw(ws) + WS_W1IN))
#define W1OUT ((bf16_t*)(lw(ws) + WS_W1OUT))
#define W1GU  ((bf16_t*)(lw(ws) + WS_W1GU))
#define W1DN  ((bf16_t*)(lw(ws) + WS_W1DN))
#define XN    ((bf16_t*)(lw(ws) + WS_XN))
#define H     ((bf16_t*)(lw(ws) + WS_H))
#define PROJ  ((bf16_t*)(lw(ws) + WS_PROJ))
#define CAT   ((bf16_t*)(lw(ws) + WS_CAT))
#define HID   ((bf16_t*)(lw(ws) + WS_HID))
#define PP    ((float*)(lw(ws) + WS_PP))
#define KCB   ((bf16_t*)(lw(ws) + WS_KC))
#define VCB   ((bf16_t*)(lw(ws) + WS_VC))
#define SSXI(k) ((float*)(lw(ws) + WS_SSX) + (size_t)(k) * 68 * 256 * 8)
#define CNTI(k) ((unsigned*)(lw(ws) + WS_CNT) + (k) * 68 * 64)
#ifndef ONLY_PHASE
#define ONLY_PHASE -1
#endif
#define PH(k) (ONLY_PHASE < 0 || ONLY_PHASE == (k))
#define A (*Ap)
#define GRID_BAR() xcd_barrier(bar)
template <int layer, bool FIXED>
__device__ __forceinline__ void attn_units(const __attribute__((address_space(4))) Args* Ap, unsigned char* ws, unsigned char* lds, const int c, const int nunits, const float sbound) {
      for (int i = 0; ; ++i) {
        const int L = i * 256 + c; if (L >= nunits || i >= 4) break;
        att::UnitArgs u;
        if (L < 768) { int b, h, qb; attn_decode(i, c, b, h, qb);
          u.qrow0 = b * SEQ + qb * 256; u.qcol = h * 128; u.kvbase = (b * 4 + h / 3) * 4352 * 128;
          u.tpos0 = qb * 256; u.rope = 1; u.ocol = h * 128; u.nB = -sbound;
          if (layer == 0) { u.kstart = 0; u.NT = 68; u.sinkl2 = 0.f; u.has_sink = 0; }
          else { u.kstart = qb * 256 - 128; u.NT = 12; u.sinkl2 = gptr(A.l1_sink)[h] * 1.4426950408889634f; u.has_sink = 1; }
        } else { const int j = L - 768, b = j / 12, h = j % 12;
          u.qrow0 = MLAT + b * CTXL; u.qcol = h * 128; u.kvbase = (b * 4 + h / 3) * 4352 * 128;
          u.tpos0 = 0; u.rope = 0; u.ocol = h * 128; u.kstart = 0; u.NT = 4; u.sinkl2 = 0.f; u.has_sink = 0; u.nB = -sbound; }
        if constexpr (layer == 0) att::attn_unit<LDP0, false, FIXED>(PROJ, KCB, VCB, CAT, gptr(A.l0_q_g), u, (char*)lds);
        else att::attn_unit<LDP1, true, FIXED>(PROJ, KCB, VCB, CAT, gptr(A.l1_q_g), u, (char*)lds);
        __syncthreads();
      }
}
template <int layer>
__device__ __forceinline__ void layer_fwd(const __attribute__((address_space(4))) Args* Ap, unsigned char* ws, unsigned char* lds, const XcdBarrier bar, const int G, const int c) {
  int tid_ = threadIdx.x; asm volatile("" : "+v"(tid_));
  const int tid = tid_, lane = tid & 63, wave = __builtin_amdgcn_readfirstlane(tid >> 6), gw = c * NWAVES + wave, ngw = G * NWAVES; (void)tid;
  PG8_LAS unsigned char* ldsl = (PG8_LAS unsigned char*)lds;
    const float* mod = MOD + (size_t)layer * 5 * NMOD;
    const int Mrows = layer == 0 ? MALL : MLAT;
    if constexpr (layer == 0) {
      if (PH(3)) norm_mod_rows<false, false>(gptr(A.x), gptr(A.ctx), MALL, gptr(A.l0_norm1_g), mod, 0, 2048, XN, gw, ngw, lane);
      GRID_BAR();
    }
    if (PH(4)) {
      if constexpr (layer == 1) {
        norm_mod_rows<true, true>(H, H + (size_t)MLAT * DM, MALL, gptr(A.l1_norm1_g), mod, 0, 2048, XN, gw, ngw, lane, PP, MOD + 4 * NMOD + 5 * 2048, MLAT);
        if (gw < MCTX) { __builtin_amdgcn_fence(__ATOMIC_RELEASE, "agent"); asm volatile("s_waitcnt vmcnt(0)" ::: "memory");
          if (lane == 0) __hip_atomic_fetch_add((unsigned*)(lw(ws) + WS_CNTX), 1u, __ATOMIC_RELAXED, __HIP_MEMORY_SCOPE_AGENT); }
      }
      pg8::Gemm g{XN, layer == 0 ? W0IN : W1IN, layer == 0 ? MALL : MLAT, layer == 0 ? LDP0 : LDP1, DM, DM}; pg8::StaticOrder S; S.init(g.M, g.N, G, c);
      pg8::EpiStoreBf16 E{PROJ, g.N, VCB};
      pg8::gemm_phase<pg8::EpiStoreBf16, pg8::StaticOrder, true, true>(ldsl, g, S, E);
      if (layer == 1) {
        if (c < 128) {
          if (threadIdx.x == 0) { unsigned sp = 0; unsigned* cx = (unsigned*)(lw(ws) + WS_CNTX);
            while (__hip_atomic_load(cx, __ATOMIC_RELAXED, __HIP_MEMORY_SCOPE_AGENT) < (unsigned)MCTX) { __builtin_amdgcn_s_sleep(2); if (++sp > (1u << 22)) break; }
            __builtin_amdgcn_fence(__ATOMIC_ACQUIRE, "agent"); asm volatile("s_waitcnt vmcnt(0)" ::: "memory"); }
          __syncthreads();
          pg8::Gemm g2{XN, W1IN, MALL, LDP1, 256, DM}; pg8::CtxSplitOrder S2{8, 4, 6, 128, G, c}; pg8::EpiPartF32 E2{PP, 1024, 1536};
          pg8::gemm_phase<pg8::EpiPartF32, pg8::CtxSplitOrder, true, true>(ldsl, g2, S2, E2); } }
      if (layer == 0 && c >= 64) {
        constexpr int I_IN1 = 32 * 48, I_OUT1 = 24 * 32, I_GU = 32 * 88, I_DN = 88 * 32; int ln = lane; asm volatile("" : "+v"(ln));
        for (int it = (c - 64) * NWAVES + wave; it < I_IN1 + I_OUT1 + 2 * I_GU; it += 192 * NWAVES) { int r = it;
          if (r < I_IN1) { tr_item<0>(gptr(A.l1_w_in), 3072, W1IN, DM, r, ln); continue; } r -= I_IN1;
          if (r < I_OUT1) { tr_item<0>(gptr(A.l1_w_out), DM, W1OUT, DM, r, ln); continue; } r -= I_OUT1;
          if (r < I_GU) { tr_item<1>(gptr(A.l1_w_gate), FFN, W1GU, DM, r, ln); continue; } r -= I_GU;
          tr_item<2>(gptr(A.l1_w_up), FFN, W1GU, DM, r, ln); } }
    }
    GRID_BAR();
    if (PH(5)) { int ln = lane; asm volatile("" : "+v"(ln)); if (layer == 0) { for (int row = gw; row < MALL; row += ngw) { knorm_row<LDP0>(PROJ, KCB, VCB, row, gptr(A.l0_k_g), ln); conv_row(PROJ, CAT, row, gptr(A.l0_conv_w), ln); } }
    else            { for (int row = gw; row < MALL; row += ngw) { if (row < MLAT) { knorm_row<LDP1>(PROJ, KCB, VCB, row, gptr(A.l1_k_g), ln); pool_row(PROJ, CAT, row, ln); } else kv_ctx_from_part(PP, KCB, VCB, row, gptr(A.l1_k_g), ln); } } }
    GRID_BAR();
    if (PH(6)) {
      const int nunits = layer == 0 ? 816 : 768;
      float sbound; { const float* qgp = layer == 0 ? gptr(A.l0_q_g) : gptr(A.l1_q_g); const float* kgp = layer == 0 ? gptr(A.l0_k_g) : gptr(A.l1_k_g);
        float mq = fmaxf(fabsf(qgp[lane]), fabsf(qgp[lane + 64])), mk = fmaxf(fabsf(kgp[lane]), fabsf(kgp[lane + 64]));
#pragma unroll
        for (int o = 1; o < 64; o <<= 1) { mq = fmaxf(mq, __shfl_xor(mq, o)); mk = fmaxf(mk, __shfl_xor(mk, o)); }
        sbound = 128.0f * mq * mk * att::SCALE * 1.4426950408889634f * 1.02f; }
      const bool fixed_sm = __builtin_amdgcn_readfirstlane(sbound <= 60.0f ? 1 : 0) != 0;
      if (fixed_sm) attn_units<layer, true>(Ap, ws, lds, c, nunits, sbound); else attn_units<layer, false>(Ap, ws, lds, c, nunits, sbound);
      if (layer == 0 && c >= 48) {
        const int idx = c - 48;
        if (idx < 128) mod_item(gptr(A.l0_w_mod), gptr(A.l0_b_mod), gptr(A.c), gptr(A.c_ctx), MOD, 64 + idx, lds);
        else { int ln = lane; asm volatile("" : "+v"(ln));
          for (int it = (idx - 128) * NWAVES + wave; it < 32 * 32; it += 80 * NWAVES) tr_item<0>(gptr(A.l0_w_out), DM, W0OUT, DM, it, ln); } }
    }
    GRID_BAR();
    if (PH(7)) {
      pg8::Gemm g{CAT, layer == 0 ? W0OUT : W1OUT, Mrows, DM, DM, DM}; pg8::PanelOrder S{Mrows / 256, G, c};
      if constexpr (layer == 0) { pg8::EpiResNorm<false, 0> E{gptr(A.x), gptr(A.ctx) - (size_t)MLAT * DM, mod + 2 * 2048, H, XN, nullptr, gptr(A.l0_norm2_g), mod + 4 * 2048, mod + 3 * 2048, SSXI(0), CNTI(0), ldsl + 131072 + 2048};
        pg8::gemm_phase<pg8::EpiResNorm<false, 0>, pg8::PanelOrder, true, true>(ldsl, g, S, E); }
      else { pg8::EpiResNorm<true, 0> E{H, H, mod + 2 * 2048, H, XN, nullptr, gptr(A.l1_norm2_g), mod + 4 * 2048, mod + 3 * 2048, SSXI(2), CNTI(2), ldsl + 131072 + 2048};
        pg8::gemm_phase<pg8::EpiResNorm<true, 0>, pg8::PanelOrder, true, true>(ldsl, g, S, E); }
      if (layer == 0 && !(c < 64 && (c & 7) < 4)) {
        const int idx = c >= 64 ? 32 + (c - 64) : (c >> 3) * 4 + ((c & 7) - 4);
        constexpr int I_GU = 32 * 88, I_DN = 88 * 32; int ln = lane; asm volatile("" : "+v"(ln));
        for (int it = idx * NWAVES + wave; it < 2 * I_GU + I_DN; it += 224 * NWAVES) { int r = it;
          if (r < I_GU) { tr_item<1>(gptr(A.l0_w_gate), FFN, W0GU, DM, r, ln); continue; } r -= I_GU;
          if (r < I_GU) { tr_item<2>(gptr(A.l0_w_up), FFN, W0GU, DM, r, ln); continue; } r -= I_GU;
          tr_item<0>(gptr(A.l0_w_down), DM, W0DN, FFN, r, ln); } }
    }
    GRID_BAR();
    if (PH(9)) {
      pg8::Gemm g{XN, layer == 0 ? W0GU : W1GU, Mrows, 2 * FFN, DM, DM}; pg8::StaticOrder S; S.init(g.M, g.N, G, c);
      pg8::EpiSwiGLU E{HID, FFN};
      pg8::gemm_phase<pg8::EpiSwiGLU, pg8::StaticOrder, true, true>(ldsl, g, S, E);
      if (layer == 0 && c >= 176) {
        for (int it = c - 176; it < 192; it += 80) mod_item(gptr(A.l1_w_mod), gptr(A.l1_b_mod), gptr(A.c), gptr(A.c_ctx), MOD + (size_t)5 * NMOD, it, lds); }
    }
    GRID_BAR();
    if (PH(10)) {
      pg8::Gemm g{HID, layer == 0 ? W0DN : W1DN, MLAT, DM, FFN, FFN}; pg8::PanelOrder S{MLAT / 256, G, c};
      if constexpr (layer == 0) { const float* mod1 = MOD + (size_t)5 * NMOD;
        pg8::EpiResNorm<true, 0> E{H, H, mod + 5 * 2048, H, XN, nullptr, gptr(A.l1_norm1_g), mod1 + 2048, mod1, SSXI(1), CNTI(1), ldsl + 131072 + 2048};
        pg8::gemm_phase<pg8::EpiResNorm<true, 0>, pg8::PanelOrder, true, true>(ldsl, g, S, E); }
      else { pg8::EpiResNorm<true, 1> E{H, H, mod + 5 * 2048, nullptr, nullptr, gptr(A.out), gptr(A.final_g), nullptr, nullptr, SSXI(3), CNTI(3), ldsl + 131072 + 2048};
        pg8::gemm_phase<pg8::EpiResNorm<true, 1>, pg8::PanelOrder, true, true>(ldsl, g, S, E); }
      if (layer == 0) {
        if (c < 128) { pg8::Gemm g2{HID, W0DN, MALL, DM, 1408, FFN}; pg8::CtxSplitOrder S2{4, 8, 0, 128, G, c}; pg8::EpiPartF32 E2{PP, 2048, 0};
          pg8::gemm_phase<pg8::EpiPartF32, pg8::CtxSplitOrder, true, true>(ldsl, g2, S2, E2);
 }
        else { const int idx = c - 128; fold_item(gptr(A.l1_w_out), gptr(A.l1_pool_scale), gptr(A.l1_pool_w), W1OUT, idx, lds); int ln = lane; asm volatile("" : "+v"(ln));
          for (int it = idx * NWAVES + wave; it < 88 * 32; it += 128 * NWAVES) tr_item<0>(gptr(A.l1_w_down), DM, W1DN, FFN, it, ln); }
      }
    }
    if (layer == 0) GRID_BAR();
}
__global__ void __launch_bounds__(NTHR, 2) fwd_mega(Args Araw) {
  const __attribute__((address_space(4))) Args* Ap = (const __attribute__((address_space(4))) Args*)__builtin_amdgcn_kernarg_segment_ptr();
  asm volatile("" : "+s"(Ap));
  extern __shared__ __attribute__((aligned(16))) unsigned char lds[];
  cg::grid_group grid = cg::this_grid();
  const int tid = threadIdx.x, lane = tid & 63, wave = __builtin_amdgcn_readfirstlane(tid >> 6);
  const int G = gridDim.x, c = blockIdx.x, gw = c * NWAVES + wave, ngw = G * NWAVES;
  unsigned char* ws = gptr(A.ws);
  PG8_LAS unsigned char* ldsl = (PG8_LAS unsigned char*)lds;
  volatile LAS unsigned* bst = (volatile LAS unsigned*)((LAS unsigned char*)lds + 131072 + 1024);
  if (tid < 64) ((LAS unsigned*)((LAS unsigned char*)lds + 131072 + 1024))[tid] = 0u;
  __syncthreads();
  XcdBarrier bar = xcd_barrier_post((unsigned*)(ws + WS_BAR), bst);

  if (PH(0)) {
    if (c < 128) mod_item<32>(gptr(A.l0_w_mod), gptr(A.l0_b_mod), gptr(A.c), gptr(A.c_ctx), MOD, c, lds);
    else { int ln = lane; asm volatile("" : "+v"(ln));
      for (int it = (c - 128) * NWAVES + wave; it < 32 * 64; it += 128 * NWAVES) tr_item<0>(gptr(A.l0_w_in), 4096, W0IN, DM, it, ln); }
  }
  GRID_BAR();
  if (gridDim.x == 0x7fffffu) grid.sync();

  layer_fwd<0>(Ap, ws, lds, bar, G, c);
  layer_fwd<1>(Ap, ws, lds, bar, G, c);
#undef A
}
#undef MOD
#undef W0IN
#undef W0OUT
#undef W0GU
#undef W0DN
#undef W1IN
#undef W1OUT
#undef W1GU
#undef W1DN
#undef XN
#undef H
#undef PROJ
#undef CAT
#undef HID
#undef PP
#undef KCB
#undef VCB
#undef SSXI
#undef CNTI


extern "C" void kernel_launch(void* const* d_in, const int* in_sizes, int n_in, void* d_out, int out_size, void* d_ws, size_t ws_size, hipStream_t stream) {
  static int grid_blocks = 0;
  if (grid_blocks == 0) {
    if (n_in != 31 || in_sizes[0] != MLAT * DM || out_size != MLAT * DM || ws_size < WS_END) {
      fprintf(stderr, "kernel_launch: unexpected problem: n_in %d in0 %d out %d ws %zu (need %zu)\n", n_in, n_in > 0 ? in_sizes[0] : -1, out_size, ws_size, (size_t)WS_END); grid_blocks = -1; return; }
    int dev = 0, cus = 0, per_cu = 0;
    hipGetDevice(&dev); hipDeviceGetAttribute(&cus, hipDeviceAttributeMultiprocessorCount, dev);
    if (hipFuncSetAttribute((const void*)fwd_mega, hipFuncAttributeMaxDynamicSharedMemorySize, LDS_BYTES) != hipSuccess) { fprintf(stderr, "kernel_launch: hipFuncSetAttribute failed\n"); grid_blocks = -1; return; }
    hipOccupancyMaxActiveBlocksPerMultiprocessor(&per_cu, (const void*)fwd_mega, NTHR, LDS_BYTES);
    (void)hipGetLastError();
    if (per_cu < 1) per_cu = 1;
    grid_blocks = cus;
    if (grid_blocks != 256) fprintf(stderr, "kernel_launch: note: %d CUs (kernel assumes a 256-workgroup grid for its static work split)\n", grid_blocks);
    grid_blocks = 256;
  }
  if (grid_blocks < 0) return;
  if (hipMemsetAsync((char*)d_ws, 0, ZERO_BYTES, stream) != hipSuccess) { fprintf(stderr, "kernel_launch: memset failed\n"); return; }
  Args a{};
  const float** p = (const float**)&a;
  for (int i = 0; i < 31; ++i) p[i] = (const float*)d_in[i];
  a.out = (float*)d_out; a.ws = (unsigned char*)d_ws;
  void* args[] = {&a};
  hipError_t e = hipLaunchCooperativeKernel((const void*)fwd_mega, dim3(grid_blocks), dim3(NTHR), args, LDS_BYTES, stream);
  if (e != hipSuccess) fprintf(stderr, "kernel_launch: cooperative launch failed: %s\n", hipGetErrorString(e));
}
```
